# Optimizing an MI355X kernel written in HIP

```python
import jax, jax.numpy as jnp
from jax import lax
import numpy as np

D_MODEL = 1024
BATCH = 8
SEQ = 4096
DEPTH = 2

D_MIX = D_MODEL
N_MIXERS = 4
G_WIDTH = D_MIX // N_MIXERS
HEAD_DIM = 64
N_GROUP_HEADS = G_WIDTH // HEAD_DIM
D_FF = 2816
RMS_EPS = 1e-6
POOL_WINDOWS = (2, 4, 8, 16)
POOL_CH = G_WIDTH // len(POOL_WINDOWS)
RWKV_HEADS = N_GROUP_HEADS
RWKV_N = HEAD_DIM
RWKV_W_RANK = 64
RWKV_A_RANK = 32
RWKV_G_RANK = 64
RWKV_SIZES = (G_WIDTH, G_WIDTH, G_WIDTH, RWKV_W_RANK, RWKV_A_RANK, RWKV_G_RANK)
RWKV_COLS = sum(RWKV_SIZES)
RWKV_LN_EPS = 64e-5
NSA_HEADS = N_GROUP_HEADS
NSA_CMP_LEN = 32
NSA_CMP_STRIDE = 16
NSA_CMP_HIDDEN = 128
NSA_SEL_BLOCK = 64
NSA_TOP_N = 16
NSA_WINDOW = 512
NSA_QBLK = 64
NSA_FORCE_BONUS = 1e4
NSA_NEG = -1e9
NSA_SIZES = (G_WIDTH,) + (HEAD_DIM,) * 6 + (3 * NSA_HEADS,)
NSA_COLS = sum(NSA_SIZES)
CONV_WIDTH = 3
CONV_COLS = 3 * G_WIDTH
P_SIZES = (G_WIDTH, RWKV_COLS, NSA_COLS, CONV_COLS)
P_TOTAL = sum(P_SIZES)

kernel_name = "hybrid_parallel_heads_block"


def _splits(sizes):
    return [int(s) for s in np.cumsum(sizes)[:-1]]


def rms_norm(x, g, eps=RMS_EPS):
    xf = x.astype(jnp.float32)
    y = xf * lax.rsqrt(jnp.mean(xf * xf, axis=-1, keepdims=True) + eps)
    return (y * g.astype(jnp.float32)).astype(x.dtype)


def swiglu_ffn(x, g, w_gate, w_up, w_down):
    h = rms_norm(x, g)
    return (jax.nn.silu(h @ w_gate) * (h @ w_up)) @ w_down


def token_shift(u):
    return jnp.pad(u, ((0, 0), (1, 0), (0, 0)))[:, :-1]


def alibi_slopes(h):
    return 2.0 ** (-8.0 * jnp.arange(1, h + 1, dtype=jnp.float32) / h)


def pool_mixer(u, pool_w, pool_scale):
    B, S, _ = u.shape
    c = jnp.pad(jnp.cumsum(u.astype(jnp.float32), axis=1), ((0, 0), (1, 0), (0, 0)))
    t = jnp.arange(S)
    outs = []
    for gi, w in enumerate(POOL_WINDOWS):
        sl = slice(gi * POOL_CH, (gi + 1) * POOL_CH)
        lo = jnp.maximum(t + 1 - w, 0)
        total = c[:, 1:, sl] - c[:, lo, sl]
        cnt = (t + 1 - lo).astype(jnp.float32)[None, :, None]
        outs.append(total / cnt)
    pooled = jnp.stack(outs, axis=2).astype(u.dtype)
    ug = u.reshape(B, S, len(POOL_WINDOWS), POOL_CH)
    y = jnp.einsum('bsgc,gcd->bsgd', pooled - ug, pool_w).reshape(B, S, G_WIDTH)
    return y * pool_scale


def _rwkv_step(state, inp):
    r_t, k_t, v_t, w_t, kk_t, akk_t = inp
    sa = jnp.einsum('bhvk,bhk->bhv', state, kk_t)
    state = (state * w_t[:, :, None, :]
             - sa[..., None] * akk_t[:, :, None, :]
             + v_t[..., None] * k_t[:, :, None, :])
    y = jnp.einsum('bhvk,bhk->bhv', state, r_t)
    return state, y


def rwkv7_mixer(p, mu, w0, w_up, a0, a_up, g_up, k_k, k_a, r_k, ln_w, ln_b):
    B, S, _ = p.shape
    H, N = RWKV_HEADS, RWKV_N
    p = p + mu * (token_shift(p) - p)
    r, k, v, wd, ad, gd = jnp.split(p, _splits(RWKV_SIZES), axis=-1)
    w = (w0 + jnp.tanh(wd) @ w_up).astype(jnp.float32)
    decay = jnp.exp(-jnp.exp(-jax.nn.softplus(-w) - 0.5))
    a = jax.nn.sigmoid(a0 + ad @ a_up)
    g = jax.nn.sigmoid(gd) @ g_up
    kk = (k * k_k).reshape(B, S, H, N).astype(jnp.float32)
    kk = kk * lax.rsqrt(jnp.maximum(jnp.sum(kk * kk, axis=-1, keepdims=True), 1e-24))
    k = k * (1 + (a - 1) * k_a)

    def heads(z):
        return z.reshape(B, S, H, N).astype(jnp.float32)

    r_h, k_h, v_h, a_h = heads(r), heads(k), heads(v), heads(a)
    xs = tuple(jnp.swapaxes(z, 0, 1) for z in (r_h, k_h, v_h, heads(decay), kk, kk * a_h))
    state0 = jnp.zeros((B, H, N, N), jnp.float32)
    _, ys = lax.scan(_rwkv_step, state0, xs)
    y = jnp.swapaxes(ys, 0, 1)
    mean = jnp.mean(y, axis=-1, keepdims=True)
    var = jnp.mean(jnp.square(y - mean), axis=-1, keepdims=True)
    y = ((y - mean) * lax.rsqrt(var + RWKV_LN_EPS)).reshape(B, S, G_WIDTH) * ln_w + ln_b
    bonus = jnp.sum(r_h * k_h * r_k, axis=-1, keepdims=True) * v_h
    out = (y + bonus.reshape(B, S, G_WIDTH)) * g
    return out.astype(p.dtype)


def nsa_mixer(p, q_norm_w, k_norm_w, cmp_pos, cmp_k_w1, cmp_k_w2, cmp_v_w1, cmp_v_w2):
    B, S, _ = p.shape
    H, Dh = NSA_HEADS, HEAD_DIM
    q, kc, vc, ksl, vsl, kwn, vwn, gates = jnp.split(p, _splits(NSA_SIZES), axis=-1)
    q = rms_norm(q.reshape(B, S, H, Dh), q_norm_w)
    scale = Dh ** -0.5
    slopes = alibi_slopes(H)
    t = jnp.arange(S)

    n_cmp = (S - NSA_CMP_LEN) // NSA_CMP_STRIDE + 1
    cmp_start = jnp.arange(n_cmp) * NSA_CMP_STRIDE
    idx = cmp_start[:, None] + jnp.arange(NSA_CMP_LEN)[None]

    def compress(u, w1, w2):
        blocks = u[:, idx] + cmp_pos
        return jax.nn.gelu(blocks.reshape(B, n_cmp, NSA_CMP_LEN * Dh) @ w1) @ w2

    k_cmp = rms_norm(compress(kc, cmp_k_w1, cmp_k_w2), k_norm_w[0])
    v_cmp = compress(vc, cmp_v_w1, cmp_v_w2)
    blk_end = cmp_start + NSA_CMP_LEN - 1
    dist = (t[:, None] - blk_end[None]).astype(jnp.float32)
    valid = dist >= 0
    s = jnp.einsum('bshd,bnd->bhsn', q, k_cmp).astype(jnp.float32) * scale - slopes[:, None, None] * dist
    s = jnp.where(valid, s, NSA_NEG)
    p_cmp = jax.nn.softmax(s, axis=-1) * valid
    o_cmp = jnp.einsum('bhsn,bnd->bshd', p_cmp.astype(v_cmp.dtype), v_cmp)

    n_sel = S // NSA_SEL_BLOCK
    n_top = min(NSA_TOP_N, n_sel)
    sel_start = jnp.arange(n_sel) * NSA_SEL_BLOCK
    overlap = ((cmp_start[:, None] <= sel_start[None] + NSA_SEL_BLOCK - 1)
               & (blk_end[:, None] >= sel_start[None])).astype(jnp.float32)
    imp = jnp.einsum('bhsn,nj->bsj', p_cmp, overlap)
    cur = t // NSA_SEL_BLOCK
    j = jnp.arange(n_sel)
    sel_ok = j[None] <= cur[:, None]
    forced = (j[None] == 0) | (j[None] == cur[:, None]) | (j[None] == cur[:, None] - 1)
    imp = jnp.where(sel_ok, imp + jnp.where(forced, NSA_FORCE_BONUS, 0.0), -1.0)
    _, sel_idx = lax.top_k(imp, n_top)

    k_sel_blocks = rms_norm(ksl, k_norm_w[1]).reshape(B, n_sel, NSA_SEL_BLOCK, Dh)
    v_sel_blocks = vsl.reshape(B, n_sel, NSA_SEL_BLOCK, Dh)
    pad = ((0, 0), (NSA_WINDOW, 0), (0, 0))
    k_win_p = jnp.pad(rms_norm(kwn, k_norm_w[2]), pad)
    v_win_p = jnp.pad(vwn, pad)

    n_qb = S // NSA_QBLK
    q_b = q.reshape(B, n_qb, NSA_QBLK, H, Dh).transpose(1, 0, 2, 3, 4)
    idx_b = sel_idx.reshape(B, n_qb, NSA_QBLK, n_top).transpose(1, 0, 2, 3)
    win_len = NSA_WINDOW + NSA_QBLK

    def block_fn(args):
        i, q_i, idx_i = args
        t_i = i * NSA_QBLK + jnp.arange(NSA_QBLK)
        k_g = jax.vmap(lambda kb, ib: kb[ib])(k_sel_blocks, idx_i)
        v_g = jax.vmap(lambda vb, ib: vb[ib])(v_sel_blocks, idx_i)
        pos = idx_i[..., None] * NSA_SEL_BLOCK + jnp.arange(NSA_SEL_BLOCK)
        d = (t_i[None, :, None, None] - pos).astype(jnp.float32)
        ss = (jnp.einsum('bqhd,bqnkd->bhqnk', q_i, k_g).astype(jnp.float32) * scale
              - slopes[None, :, None, None, None] * d[:, None])
        ss = jnp.where((d >= 0)[:, None], ss, NSA_NEG).reshape(B, H, NSA_QBLK, n_top * NSA_SEL_BLOCK)
        ps = jax.nn.softmax(ss, axis=-1).reshape(B, H, NSA_QBLK, n_top, NSA_SEL_BLOCK)
        o_sel = jnp.einsum('bhqnk,bqnkd->bqhd', ps.astype(v_g.dtype), v_g)
        kw_i = lax.dynamic_slice_in_dim(k_win_p, i * NSA_QBLK, win_len, axis=1)
        vw_i = lax.dynamic_slice_in_dim(v_win_p, i * NSA_QBLK, win_len, axis=1)
        s_pos = i * NSA_QBLK - NSA_WINDOW + jnp.arange(win_len)
        dw = (t_i[:, None] - s_pos[None]).astype(jnp.float32)
        okw = (dw >= 0) & (dw < NSA_WINDOW) & (s_pos[None] >= 0)
        sw = (jnp.einsum('bqhd,bkd->bhqk', q_i, kw_i).astype(jnp.float32) * scale
              - slopes[None, :, None, None] * dw[None, None])
        sw = jnp.where(okw, sw, NSA_NEG)
        pw = jax.nn.softmax(sw, axis=-1)
        o_win = jnp.einsum('bhqk,bkd->bqhd', pw.astype(vw_i.dtype), vw_i)
        return o_sel, o_win

    o_sel, o_win = lax.map(block_fn, (jnp.arange(n_qb), q_b, idx_b))
    o_sel = o_sel.transpose(1, 0, 2, 3, 4).reshape(B, S, H, Dh)
    o_win = o_win.transpose(1, 0, 2, 3, 4).reshape(B, S, H, Dh)
    gt = jax.nn.sigmoid(gates).reshape(B, S, H, 3)
    out = gt[..., 0:1] * o_cmp + gt[..., 1:2] * o_sel + gt[..., 2:3] * o_win
    return out.reshape(B, S, G_WIDTH)


def short_conv_mixer(p, conv_w):
    u, b, c = jnp.split(p, 3, axis=-1)
    z = c * u
    S = z.shape[1]
    zp = jnp.pad(z, ((0, 0), (CONV_WIDTH - 1, 0), (0, 0)))
    y = conv_w[0] * zp[:, 0:S]
    for jw in range(1, CONV_WIDTH):
        y = y + conv_w[jw] * zp[:, jw:jw + S]
    return b * y


def setup_inputs(seed: int = 0) -> dict:
    key = jax.random.key(seed)
    keys = iter(jax.random.split(key, 48))
    f32 = jnp.float32

    def nrm(shape, scale):
        return scale * jax.random.normal(next(keys), shape, f32)

    def gain(shape):
        return 1.0 + nrm(shape, 0.02)

    def unif(shape, lo, hi):
        return jax.random.uniform(next(keys), shape, f32, lo, hi)

    L, D, F, G, Dh = DEPTH, D_MODEL, D_FF, G_WIDTH, HEAD_DIM
    cmp_in = NSA_CMP_LEN * Dh
    return {
        "x": nrm((BATCH, SEQ, D), 1.0),
        "ffn1_norm": gain((L, D)),
        "ffn1_w_gate": nrm((L, D, F), D ** -0.5),
        "ffn1_w_up": nrm((L, D, F), D ** -0.5),
        "ffn1_w_down": nrm((L, F, D), F ** -0.5),
        "mix_norm": gain((L, D)),
        "w_in": nrm((L, D, P_TOTAL), D ** -0.5),
        "pool_w": nrm((L, len(POOL_WINDOWS), POOL_CH, POOL_CH), POOL_CH ** -0.5),
        "pool_scale": 1.0 + nrm((L, G), 0.1),
        "rwkv_mu": unif((L, RWKV_COLS), 0.0, 1.0),
        "rwkv_w0": unif((L, G), -6.0, -1.0),
        "rwkv_w_up": nrm((L, RWKV_W_RANK, G), 0.1 * RWKV_W_RANK ** -0.5),
        "rwkv_a0": nrm((L, G), 0.3),
        "rwkv_a_up": nrm((L, RWKV_A_RANK, G), 0.1 * RWKV_A_RANK ** -0.5),
        "rwkv_g_up": nrm((L, RWKV_G_RANK, G), RWKV_G_RANK ** -0.5),
        "rwkv_k_k": 0.85 + nrm((L, G), 0.1),
        "rwkv_k_a": 1.0 + nrm((L, G), 0.1),
        "rwkv_r_k": nrm((L, RWKV_HEADS, RWKV_N), 0.1),
        "rwkv_ln_w": gain((L, G)),
        "rwkv_ln_b": nrm((L, G), 0.02),
        "nsa_q_norm": gain((L, Dh)),
        "nsa_k_norm": gain((L, 3, Dh)),
        "nsa_cmp_pos": nrm((L, NSA_CMP_LEN, Dh), 0.1),
        "nsa_cmp_k_w1": nrm((L, cmp_in, NSA_CMP_HIDDEN), cmp_in ** -0.5),
        "nsa_cmp_k_w2": nrm((L, NSA_CMP_HIDDEN, Dh), NSA_CMP_HIDDEN ** -0.5),
        "nsa_cmp_v_w1": nrm((L, cmp_in, NSA_CMP_HIDDEN), cmp_in ** -0.5),
        "nsa_cmp_v_w2": nrm((L, NSA_CMP_HIDDEN, Dh), NSA_CMP_HIDDEN ** -0.5),
        "conv_w": nrm((L, CONV_WIDTH, G), CONV_WIDTH ** -0.5),
        "w_out": nrm((L, D_MIX, D), D_MIX ** -0.5),
        "ffn2_norm": gain((L, D)),
        "ffn2_w_gate": nrm((L, D, F), D ** -0.5),
        "ffn2_w_up": nrm((L, D, F), D ** -0.5),
        "ffn2_w_down": nrm((L, F, D), F ** -0.5),
    }


def reference(x, ffn1_norm, ffn1_w_gate, ffn1_w_up, ffn1_w_down, mix_norm, w_in,
              pool_w, pool_scale,
              rwkv_mu, rwkv_w0, rwkv_w_up, rwkv_a0, rwkv_a_up, rwkv_g_up, rwkv_k_k, rwkv_k_a,
              rwkv_r_k, rwkv_ln_w, rwkv_ln_b,
              nsa_q_norm, nsa_k_norm, nsa_cmp_pos, nsa_cmp_k_w1, nsa_cmp_k_w2, nsa_cmp_v_w1,
              nsa_cmp_v_w2,
              conv_w, w_out, ffn2_norm, ffn2_w_gate, ffn2_w_up, ffn2_w_down):
    for l in range(DEPTH):
        x = x + 0.5 * swiglu_ffn(x, ffn1_norm[l], ffn1_w_gate[l], ffn1_w_up[l], ffn1_w_down[l])
        h = rms_norm(x, mix_norm[l])
        p = h @ w_in[l]
        p_a, p_b, p_c, p_d = jnp.split(p, _splits(P_SIZES), axis=-1)
        y_a = pool_mixer(p_a, pool_w[l], pool_scale[l])
        y_b = rwkv7_mixer(p_b, rwkv_mu[l], rwkv_w0[l], rwkv_w_up[l], rwkv_a0[l], rwkv_a_up[l],
                          rwkv_g_up[l], rwkv_k_k[l], rwkv_k_a[l], rwkv_r_k[l], rwkv_ln_w[l],
                          rwkv_ln_b[l])
        y_c = nsa_mixer(p_c, nsa_q_norm[l], nsa_k_norm[l], nsa_cmp_pos[l], nsa_cmp_k_w1[l],
                        nsa_cmp_k_w2[l], nsa_cmp_v_w1[l], nsa_cmp_v_w2[l])
        y_d = short_conv_mixer(p_d, conv_w[l])
        y = jnp.concatenate([y_a, y_b.astype(y_a.dtype), y_c.astype(y_a.dtype), y_d], axis=-1)
        x = x + y @ w_out[l]
        x = x + 0.5 * swiglu_ffn(x, ffn2_norm[l], ffn2_w_gate[l], ffn2_w_up[l], ffn2_w_down[l])
    return x
```

```cpp
#include <hip/hip_runtime.h>
#include <hip/hip_cooperative_groups.h>
#include <cstdio>
#include <cstdint>
namespace cg = cooperative_groups;
#ifndef MK_COOP
#define MK_COOP 1
#endif
namespace pg8 {
#define PG8_LAS __attribute__((address_space(3)))
typedef unsigned short bf16_t;
typedef short bf16x8 __attribute__((ext_vector_type(8)));
typedef float f32x4 __attribute__((ext_vector_type(4)));
typedef unsigned u32x4 __attribute__((ext_vector_type(4)));
constexpr int BM = 256, BK = 64, HALF = 128, HTB = HALF * BK * 2  , STAGE_BYTES = 8 * HTB, NXCD = 8, WGM = 8;

__host__ __device__ __forceinline__ int lds_byte(int r, int c) { const int st = (r >> 4) * 2 + (c >> 5), rr = r & 15, cc = c & 31, ob = rr * 64 + cc * 2; return st * 1024 + (ob ^ (((ob >> 9) & 1) << 5)); }
__host__ __device__ __forceinline__ void stage_rc(int b, int& R, int& C) { const int st = b / 1024, sb = b % 1024, swz = sb ^ (((sb >> 9) & 1) << 5); R = (st >> 1) * 16 + swz / 64; C = (st & 1) * 32 + (swz % 64) / 2; }
__host__ __device__ __forceinline__ int perm32(int rho) { const int n = rho >> 4, i = rho & 15; return 8 * (i >> 2) + 4 * n + (i & 3); }

struct Unit { int pm, pn; };
struct Gemm { const bf16_t* A; const bf16_t* Bt; int M, N, K; };

struct StaticOrder {
    int nM, nN, nwg, G, c;
    __host__ __device__ void init(int M, int N, int G_, int c_) { nM = M / BM; nN = N / BM; nwg = nM * nN; G = G_; c = c_; }
    __host__ __device__ bool next(int i, Unit& u) const {
        const long L = (long)i * G + c; if (L >= nwg) return false;
        int wgid = (int)L; { const int q = nwg / NXCD, r = nwg % NXCD, xcd = wgid % NXCD, off = wgid / NXCD; wgid = (xcd < r ? xcd * (q + 1) : r * (q + 1) + (xcd - r) * q) + off; }
        const int nig = WGM * nN, gid = wgid / nig, fm = gid * WGM, gsz = (nM - fm) < WGM ? (nM - fm) : WGM;
        u.pm = fm + ((wgid % nig) % gsz); u.pn = (wgid % nig) / gsz; return true;
    }
    __device__ __forceinline__ void a_ready(const Unit&) const {}
    __device__ __forceinline__ void done(const Unit&) const {}
};

__device__ __forceinline__ unsigned cvt_pk_bf16(float lo, float hi) { unsigned r; asm volatile("v_cvt_pk_bf16_f32 %0, %1, %2" : "=v"(r) : "v"(lo), "v"(hi)); return r; }
typedef float f32x2 __attribute__((ext_vector_type(2)));
__device__ __forceinline__ float row_rs(const float* ssq, int row, int fq) {
    const f32x4 s4 = *(const f32x4*)(ssq + (size_t)row * 16 + 4 * fq);
    float s = (s4[0] + s4[1]) + (s4[2] + s4[3]);
    s += __shfl_xor(s, 16); s += __shfl_xor(s, 32);
    return rsqrtf(s * (1.0f / 1024.0f) + 1e-6f);
}
__device__ __forceinline__ void row_rs8(const float* __restrict__ ssq, int row0, int fq, float (&rs)[2][4]) {
    f32x4 s4[2][4];
#pragma unroll
    for (int ai = 0; ai < 2; ++ai)
#pragma unroll
        for (int m = 0; m < 4; ++m) s4[ai][m] = *(const f32x4*)(ssq + (size_t)(row0 + ai * HALF + m * 16) * 16 + 4 * fq);
#pragma unroll
    for (int ai = 0; ai < 2; ++ai)
#pragma unroll
        for (int m = 0; m < 4; ++m) { float s = (s4[ai][m][0] + s4[ai][m][1]) + (s4[ai][m][2] + s4[ai][m][3]); s += __shfl_xor(s, 16); s += __shfl_xor(s, 32); rs[ai][m] = rsqrtf(s * (1.0f / 1024.0f) + 1e-6f); }
}
struct EpiGU {
    static constexpr bool PERM = true, AFTER_DRAIN = false;
    bf16_t* H; const float* ssq; int ldh;
    __device__ __forceinline__ void operator()(const f32x4 (&acc)[2][2][4][2], const Unit& u, int wr, int wc, int fr, int fq) const {
        float rs8[2][4]; row_rs8(ssq, u.pm * BM + wr * 64 + fr, fq, rs8);
#pragma unroll
        for (int ai = 0; ai < 2; ++ai)
#pragma unroll
            for (int m = 0; m < 4; ++m) {
                const int row = u.pm * BM + ai * HALF + wr * 64 + m * 16 + fr;
                const float rs = rs8[ai][m], rsl = -1.4426950408889634f * rs, rs2 = rs * rs;
                float hv[8];
#pragma unroll
                for (int n = 0; n < 2; ++n) {
                    const f32x4 ag = acc[ai][0][m][n], au = acc[ai][1][m][n];
                    const f32x4 ea = ag * rsl, gu = (ag * au) * rs2;
#pragma unroll
                    for (int j = 0; j < 4; ++j) hv[4 * n + j] = gu[j] * __builtin_amdgcn_rcpf(1.0f + __builtin_amdgcn_exp2f(ea[j]));
                }
                u32x4 w; w.x = cvt_pk_bf16(hv[0], hv[1]); w.y = cvt_pk_bf16(hv[2], hv[3]); w.z = cvt_pk_bf16(hv[4], hv[5]); w.w = cvt_pk_bf16(hv[6], hv[7]);
                *(u32x4*)(H + (size_t)row * ldh + u.pn * 128 + wc * 32 + 8 * fq) = w;
            }
    }
};
struct EpiRes {
    static constexpr bool PERM = true, AFTER_DRAIN = false;
    const float* Xin; float* X; bf16_t* XB; float* ssq; float alpha;
    __device__ __forceinline__ void operator()(const f32x4 (&acc)[2][2][4][2], const Unit& u, int wr, int wc, int fr, int fq) const {
        const size_t base = (size_t)(u.pm * BM + wr * 64 + fr) * 1024 + u.pn * BM + wc * 32 + 8 * fq;
#pragma unroll
        for (int ai = 0; ai < 2; ++ai) {
            f32x4 xv[4][2][2];
#pragma unroll
            for (int m = 0; m < 4; ++m)
#pragma unroll
                for (int bj = 0; bj < 2; ++bj)
#pragma unroll
                    for (int n = 0; n < 2; ++n) xv[m][bj][n] = *(const f32x4*)(Xin + base + (size_t)(ai * HALF + m * 16) * 1024 + bj * HALF + n * 4);
            asm volatile("" ::: "memory");
#pragma unroll
            for (int m = 0; m < 4; ++m) {
                float ss = 0.f;
#pragma unroll
                for (int bj = 0; bj < 2; ++bj) {
                    const size_t off = base + (size_t)(ai * HALF + m * 16) * 1024 + bj * HALF;
                    const f32x4 x0 = xv[m][bj][0] + acc[ai][bj][m][0] * alpha, x1 = xv[m][bj][1] + acc[ai][bj][m][1] * alpha;
                    *(f32x4*)(X + off) = x0; *(f32x4*)(X + off + 4) = x1;
                    u32x4 w; w.x = cvt_pk_bf16(x0[0], x0[1]); w.y = cvt_pk_bf16(x0[2], x0[3]); w.z = cvt_pk_bf16(x1[0], x1[1]); w.w = cvt_pk_bf16(x1[2], x1[3]);
                    *(u32x4*)(XB + off) = w;
                    ss += ((x0[0] * x0[0] + x0[1] * x0[1]) + (x0[2] * x0[2] + x0[3] * x0[3])) + ((x1[0] * x1[0] + x1[1] * x1[1]) + (x1[2] * x1[2] + x1[3] * x1[3]));
                }
                ss += __shfl_xor(ss, 16); ss += __shfl_xor(ss, 32);
                if (fq == 0) ssq[(size_t)(u.pm * BM + ai * HALF + wr * 64 + m * 16 + fr) * 16 + u.pn * 4 + wc] = ss;
            }
        }
    }
};
struct EpiP {
    static constexpr bool PERM = true, AFTER_DRAIN = false;
    bf16_t* P; const float* ssq; int ldp;
    __device__ __forceinline__ void operator()(const f32x4 (&acc)[2][2][4][2], const Unit& u, int wr, int wc, int fr, int fq) const {
        float rs8[2][4]; row_rs8(ssq, u.pm * BM + wr * 64 + fr, fq, rs8);
#pragma unroll
        for (int ai = 0; ai < 2; ++ai)
#pragma unroll
            for (int m = 0; m < 4; ++m) {
                const int row = u.pm * BM + ai * HALF + wr * 64 + m * 16 + fr;
                const float rs = rs8[ai][m];
#pragma unroll
                for (int bj = 0; bj < 2; ++bj) {
                    const f32x4 v0 = acc[ai][bj][m][0] * rs, v1 = acc[ai][bj][m][1] * rs;
                    u32x4 w; w.x = cvt_pk_bf16(v0[0], v0[1]); w.y = cvt_pk_bf16(v0[2], v0[3]); w.z = cvt_pk_bf16(v1[0], v1[1]); w.w = cvt_pk_bf16(v1[2], v1[3]);
                    *(u32x4*)(P + (size_t)row * ldp + u.pn * BM + bj * HALF + wc * 32 + 8 * fq) = w;
                }
            }
    }
};
template <class Epi, class Sched, bool ALIGN_EPI = false, bool SP2 = false>
__device__ __forceinline__ void gemm_phase(PG8_LAS unsigned char* lds, const Gemm g, const Sched& S, const Epi& E) {
    int tid = threadIdx.x; asm volatile("" : "+v"(tid));
    const int wid = __builtin_amdgcn_readfirstlane(tid >> 6), lane = tid & 63, wr = wid >> 2, wc = wid & 3, fr = lane & 15, fq = lane >> 4;
    const int K = g.K, nt = K / BK;
    unsigned voffA[2], voffB[2];
#pragma unroll
    for (int i = 0; i < 2; ++i) { int R, C; stage_rc(tid * 16 + i * 8192, R, C); const int Rb = Epi::PERM ? ((R & ~31) + perm32(R & 31)) : R;
        voffA[i] = (unsigned)(R * K + C) * 2u; voffB[i] = (unsigned)(Rb * K + C) * 2u; }
    const size_t kstep = (size_t)(BK * 2);
    const size_t hstep = (size_t)HALF * K * 2;
    const size_t tstep = 2 * hstep;
    const unsigned ldsw = (unsigned)wid * 1024u;
    const int aoff = lds_byte(wr * 64 + fr, fq * 8), boff = lds_byte(wc * 32 + fr, fq * 8);
#define PG8_SA(b, h) (((b) * 2 + (h)) * HTB)
#define PG8_SB(b, h) ((4 + (b) * 2 + (h)) * HTB)
#define PG8_STAGE(bufoff, gbase, voff) do { _Pragma("unroll") for (int _i = 0; _i < 2; ++_i) \
        __builtin_amdgcn_global_load_lds((const unsigned*)((const char*)(gbase) + (voff)[_i]), (PG8_LAS unsigned*)(lds + (bufoff) + ldsw + _i * 8192), 16, 0, 0); } while (0)
#define PG8_LDA(dst, b, h) do { _Pragma("unroll") for (int m = 0; m < 4; ++m) _Pragma("unroll") for (int k = 0; k < 2; ++k) dst[m][k] = *(const PG8_LAS bf16x8*)(lds + PG8_SA(b, h) + aoff + m * 2048 + k * 1024); } while (0)
#define PG8_LDB(dst, b, h) do { _Pragma("unroll") for (int n = 0; n < 2; ++n) _Pragma("unroll") for (int k = 0; k < 2; ++k) dst[n][k] = *(const PG8_LAS bf16x8*)(lds + PG8_SB(b, h) + boff + n * 2048 + k * 1024); } while (0)
#define PG8_MMA(ai, bj, At, Bt) do { __builtin_amdgcn_s_setprio(1); _Pragma("unroll") for (int m = 0; m < 4; ++m) _Pragma("unroll") for (int n = 0; n < 2; ++n) _Pragma("unroll") for (int k = 0; k < 2; ++k) \
        acc[ai][bj][m][n] = __builtin_amdgcn_mfma_f32_16x16x32_bf16(Bt[n][k], At[m][k], acc[ai][bj][m][n], 0, 0, 0); __builtin_amdgcn_s_setprio(0); } while (0)
#define PG8_WAIT_V(n) asm volatile("s_waitcnt vmcnt(" #n ")" ::: "memory")
#define PG8_WAIT_L(n) asm volatile("s_waitcnt lgkmcnt(" #n ")" ::: "memory")
#define PG8_BAR __builtin_amdgcn_s_barrier()
#define PG8_SCHED __builtin_amdgcn_sched_barrier(0)
    Unit cur, nxt; int ui = 0;
    if (!S.next(0, cur)) return;
    f32x4 acc[2][2][4][2];
#pragma unroll
    for (int a = 0; a < 2; ++a)
#pragma unroll
        for (int b = 0; b < 2; ++b)
#pragma unroll
            for (int m = 0; m < 4; ++m)
#pragma unroll
                for (int n = 0; n < 2; ++n) acc[a][b][m][n] = (f32x4){0.f, 0.f, 0.f, 0.f};
    bf16x8 At[4][2], B0[2][2], B1[2][2];
    const char* cA = (const char*)g.A + (size_t)cur.pm * tstep; const char* cB = (const char*)g.Bt + (size_t)cur.pn * tstep;
    S.a_ready(cur);
    if constexpr (SP2) {
        PG8_STAGE(PG8_SB(0, 0), cB, voffB); PG8_STAGE(PG8_SB(0, 1), cB + hstep, voffB); PG8_STAGE(PG8_SA(0, 0), cA, voffA); PG8_STAGE(PG8_SA(0, 1), cA + hstep, voffA);
        if (wr == 1) PG8_BAR;
        PG8_WAIT_V(2); PG8_BAR;
        PG8_STAGE(PG8_SB(1, 0), cB + kstep, voffB); PG8_STAGE(PG8_SA(1, 0), cA + kstep, voffA); PG8_STAGE(PG8_SB(1, 1), cB + hstep + kstep, voffB);
        PG8_WAIT_V(6); PG8_BAR;
    } else {
        PG8_STAGE(PG8_SB(0, 0), cB, voffB); PG8_STAGE(PG8_SA(0, 0), cA, voffA); PG8_STAGE(PG8_SB(0, 1), cB + hstep, voffB); PG8_STAGE(PG8_SA(0, 1), cA + hstep, voffA);
        if (wr == 1) PG8_BAR;
        PG8_WAIT_V(4); PG8_BAR;
        PG8_STAGE(PG8_SB(1, 0), cB + kstep, voffB); PG8_STAGE(PG8_SA(1, 0), cA + kstep, voffA); PG8_STAGE(PG8_SB(1, 1), cB + hstep + kstep, voffB);
        PG8_WAIT_V(6); PG8_BAR;
    }
    for (;;) {
        const bool has_next = S.next(ui + 1, nxt);
        const char* nA = has_next ? (const char*)g.A + (size_t)nxt.pm * tstep : cA; const char* nB = has_next ? (const char*)g.Bt + (size_t)nxt.pn * tstep : cB;
        for (int t = 0; t < nt; t += 2) {
            const bool last = (t == nt - 2);
            const char* a1 = cA + (size_t)(t + 1) * kstep;
            const char* a2 = last ? nA : cA + (size_t)(t + 2) * kstep; const char* b2 = last ? nB : cB + (size_t)(t + 2) * kstep;
            const char* a3 = a2 + kstep; const char* b3 = b2 + kstep;
            if (last && has_next) S.a_ready(nxt);
            if constexpr (SP2) {
            PG8_LDB(B0, 0, 0); PG8_LDB(B1, 0, 1); PG8_SCHED; PG8_LDA(At, 0, 0); PG8_STAGE(PG8_SA(1, 1), a1 + hstep, voffA);
            PG8_WAIT_V(8); PG8_WAIT_L(0); PG8_BAR; PG8_MMA(0, 0, At, B0); PG8_MMA(0, 1, At, B1); PG8_BAR; PG8_SCHED;
            PG8_LDA(At, 0, 1); PG8_STAGE(PG8_SB(0, 0), b2, voffB); PG8_STAGE(PG8_SB(0, 1), b2 + hstep, voffB); PG8_STAGE(PG8_SA(0, 0), a2, voffA);
            PG8_WAIT_V(8); PG8_WAIT_L(0); PG8_BAR; PG8_MMA(1, 0, At, B0); PG8_MMA(1, 1, At, B1); PG8_BAR; PG8_SCHED;
            PG8_LDB(B0, 1, 0); PG8_LDB(B1, 1, 1); PG8_SCHED; PG8_LDA(At, 1, 0); PG8_STAGE(PG8_SA(0, 1), a2 + hstep, voffA);
            PG8_WAIT_V(8); PG8_WAIT_L(0); PG8_BAR; PG8_MMA(0, 0, At, B0); PG8_MMA(0, 1, At, B1); PG8_BAR; PG8_SCHED;
            PG8_LDA(At, 1, 1); PG8_STAGE(PG8_SB(1, 0), b3, voffB); PG8_STAGE(PG8_SB(1, 1), b3 + hstep, voffB); PG8_STAGE(PG8_SA(1, 0), a3, voffA);
            PG8_WAIT_V(8); PG8_WAIT_L(0); PG8_BAR; PG8_MMA(1, 0, At, B0); PG8_MMA(1, 1, At, B1); PG8_BAR; PG8_SCHED;
            } else {
            PG8_LDB(B0, 0, 0); PG8_SCHED; PG8_LDA(At, 0, 0); PG8_STAGE(PG8_SA(1, 1), a1 + hstep, voffA);
            PG8_WAIT_L(8); PG8_BAR; PG8_WAIT_L(0); PG8_MMA(0, 0, At, B0); PG8_BAR; PG8_SCHED;
            PG8_LDB(B1, 0, 1); PG8_STAGE(PG8_SB(0, 0), b2, voffB);
            PG8_BAR; PG8_WAIT_L(0); PG8_MMA(0, 1, At, B1); PG8_BAR;
            PG8_LDA(At, 0, 1); PG8_STAGE(PG8_SA(0, 0), a2, voffA);
            PG8_BAR; PG8_WAIT_L(0); PG8_MMA(1, 0, At, B0); PG8_BAR; PG8_SCHED;
            PG8_STAGE(PG8_SB(0, 1), b2 + hstep, voffB);
            PG8_WAIT_V(6); PG8_BAR; PG8_MMA(1, 1, At, B1); PG8_BAR;
            PG8_LDB(B0, 1, 0); PG8_SCHED; PG8_LDA(At, 1, 0); PG8_STAGE(PG8_SA(0, 1), a2 + hstep, voffA);
            PG8_WAIT_L(8); PG8_BAR; PG8_WAIT_L(0); PG8_MMA(0, 0, At, B0); PG8_BAR; PG8_SCHED;
            PG8_LDB(B1, 1, 1); PG8_STAGE(PG8_SB(1, 0), b3, voffB);
            PG8_BAR; PG8_WAIT_L(0); PG8_MMA(0, 1, At, B1); PG8_BAR;
            PG8_LDA(At, 1, 1); PG8_STAGE(PG8_SA(1, 0), a3, voffA);
            PG8_BAR; PG8_WAIT_L(0); PG8_MMA(1, 0, At, B0); PG8_BAR; PG8_SCHED;
            PG8_STAGE(PG8_SB(1, 1), b3 + hstep, voffB);
            PG8_WAIT_V(6); PG8_BAR; PG8_MMA(1, 1, At, B1); PG8_BAR;
            }
        }
        if constexpr (ALIGN_EPI) { if (wr == 0) PG8_BAR; }
        if constexpr (!Epi::AFTER_DRAIN) { E(acc, cur, wr, wc, fr, fq); S.done(cur); }
        if (!has_next) break;
#pragma unroll
        for (int a = 0; a < 2; ++a)
#pragma unroll
            for (int b = 0; b < 2; ++b)
#pragma unroll
                for (int m = 0; m < 4; ++m)
#pragma unroll
                    for (int n = 0; n < 2; ++n) acc[a][b][m][n] = (f32x4){0.f, 0.f, 0.f, 0.f};
        cur = nxt; cA = nA; cB = nB; ++ui;
        if constexpr (ALIGN_EPI) { if (wr == 1) PG8_BAR; }
    }
    PG8_WAIT_V(0);
    if constexpr (!ALIGN_EPI) { if (wr == 0) PG8_BAR; }
    PG8_BAR;
    if constexpr (Epi::AFTER_DRAIN) { E.fused(acc, cur, wr, wc, fr, fq, lds, wid, lane); S.done(cur); }
#undef PG8_SA
#undef PG8_SB
#undef PG8_STAGE
#undef PG8_LDA
#undef PG8_LDB
#undef PG8_MMA
#undef PG8_WAIT_V
#undef PG8_WAIT_L
#undef PG8_BAR
#undef PG8_SCHED
}
}
using pg8::bf16_t; using pg8::bf16x8; using pg8::f32x4; using pg8::u32x4;
typedef unsigned u32x2 __attribute__((ext_vector_type(2)));
#define LAS __attribute__((address_space(3)))
constexpr int NB = 8, SEQ = 4096, T = NB * SEQ, D = 1024, FF = 2816, PT = 2604, PLD = 2816, NGU = 2 * FF;
constexpr int PC_A = 0, PC_B = 256, PC_Q = 1184, PC_KC = 1440, PC_VC = 1504, PC_KS = 1568, PC_VS = 1632, PC_KW = 1696, PC_VW = 1760, PC_U = 1824, PC_BB = 2080, PC_CC = 2336, PC_G = 2592;
constexpr size_t MiB = 1u << 20;
constexpr size_t WS_CTL = 0;
constexpr size_t WS_W0 = 1 * MiB, WS_LSTRIDE = 42 * MiB;
constexpr size_t WO_F1 = 0, WO_D1 = 11 * MiB, WO_F2 = 33 * MiB / 2, WO_D2 = 55 * MiB / 2, WO_IN = 33 * MiB, WO_OUT = 77 * MiB / 2, WO_CK = 81 * MiB / 2, WO_CV = 41 * MiB;
constexpr size_t WS_CBP = 85 * MiB;
constexpr size_t WS_SSQ = 86 * MiB;
constexpr size_t WS_P = 96 * MiB, WS_H = 96 * MiB, WS_YR = 96 * MiB;
constexpr size_t WS_XB = 272 * MiB;
constexpr size_t WS_R = 272 * MiB, WS_K = 288 * MiB, WS_V = 304 * MiB, WS_KK = 320 * MiB, WS_AKK = 336 * MiB, WS_GG = 352 * MiB, WS_DEC = 368 * MiB;
constexpr size_t WS_QN = 400 * MiB, WS_KSEL = 416 * MiB, WS_VSEL = 420 * MiB, WS_KWIN = 424 * MiB, WS_VWIN = 428 * MiB, WS_GATES = 432 * MiB, WS_KCMP = 434 * MiB, WS_VCMP = 434 * MiB + 512 * 1024;
constexpr size_t WS_Y = 440 * MiB, WS_END = 504 * MiB;
constexpr int LDS_BYTES = 147456;
constexpr int NPH = 19;

struct Args { const float* in[33]; float* out; unsigned char* ws; int lo, hi; };
constexpr size_t WS_IMG = 131072, IMG_LSTRIDE = 176128, IMG_RW = 0, IMG_POOL = 94208, IMG_W2 = 131072;
constexpr size_t WS_TAB = 65536;
#define INTAB(a) ((const float* const*)((a).ws + WS_TAB))

__device__ __forceinline__ float bf_lo(unsigned u) { return __uint_as_float(u << 16); }
__device__ __forceinline__ float bf_hi(unsigned u) { return __uint_as_float(u & 0xffff0000u); }
__device__ __forceinline__ float bf2f(bf16_t h) { return __uint_as_float((unsigned)h << 16); }
__device__ __forceinline__ unsigned f2bf(float f) { unsigned u = __float_as_uint(f); return (u + 0x7fffu + ((u >> 16) & 1u)) >> 16; }
__device__ __forceinline__ unsigned pk2(float lo, float hi) { return pg8::cvt_pk_bf16(lo, hi); }
__device__ __forceinline__ float sigmoidf_(float x) { return __builtin_amdgcn_rcpf(1.0f + __expf(-x)); }
#define LDS_WAIT() asm volatile("s_waitcnt lgkmcnt(0)" ::: "memory")
__device__ __forceinline__ f32x4 mma16(const LAS bf16_t* A, int lda, const LAS bf16_t* Bt, int ldb, int K, int lane, f32x4 acc) {
    const LAS bf16_t* ap = A + (lane & 15) * lda + (lane >> 4) * 8;
    const LAS bf16_t* bp = Bt + (lane & 15) * ldb + (lane >> 4) * 8;
    for (int k0 = 0; k0 < K; k0 += 32) {
        const bf16x8 av = *(const LAS bf16x8*)(ap + k0), bv = *(const LAS bf16x8*)(bp + k0);
        acc = __builtin_amdgcn_mfma_f32_16x16x32_bf16(bv, av, acc, 0, 0, 0);
    }
    return acc;
}
__device__ __forceinline__ float red8(float v) { v += __shfl_xor(v, 1); v += __shfl_xor(v, 2); v += __shfl_xor(v, 4); return v; }
__device__ __forceinline__ float red16(float v) { v += __shfl_xor(v, 1); v += __shfl_xor(v, 2); v += __shfl_xor(v, 4); v += __shfl_xor(v, 8); return v; }
template <int CTRL> __device__ __forceinline__ float dpp_add(float x) {
    return x + __builtin_bit_cast(float, __builtin_amdgcn_update_dpp(0, __builtin_bit_cast(int, x), CTRL, 0xf, 0xf, true));
}
template <int CTRL> __device__ __forceinline__ float dpp_get(float x) { return __builtin_bit_cast(float, __builtin_amdgcn_update_dpp(0, __builtin_bit_cast(int, x), CTRL, 0xf, 0xf, true)); }
__device__ __forceinline__ float allred16_dpp(float x) { x = dpp_add<0x128>(x); x = dpp_add<0x124>(x); x = dpp_add<0x122>(x); x = dpp_add<0x121>(x); return x; }

constexpr size_t WS_BAR = 32768;
#define XB_TMO      128
#define XB_XCNT(j)  (256  + 64 * (j))
#define XB_XSUB(j)  (1280 + 64 * (j))
#define XB_XGEN(j)  (2304 + 64 * (j))
#define XB_TOP      3328
#define XB_TOPGEN   3392
#define XCD_BAR_WORDS 3456
#define XB_SPIN_CAP (1u << 18)

__device__ __forceinline__ unsigned xb_ld(unsigned* p)              { return __hip_atomic_load(p, __ATOMIC_RELAXED, __HIP_MEMORY_SCOPE_AGENT); }
__device__ __forceinline__ unsigned xb_add(unsigned* p, unsigned v) { return __hip_atomic_fetch_add(p, v, __ATOMIC_RELAXED, __HIP_MEMORY_SCOPE_AGENT); }
__device__ __forceinline__ unsigned xb_xcc_id() { return (unsigned)__builtin_amdgcn_s_getreg((3 << 11) | 20) & 0xFu; }
#define XB_SPIN(cond, bar) do { unsigned _sp = 0; while (cond) { __builtin_amdgcn_s_sleep(1); \
    if ((++_sp & 255u) == 0u) { if (xb_ld(&(bar)[XB_TMO])) break; if (_sp > XB_SPIN_CAP) { atomicAdd(&(bar)[XB_TMO], 1u); break; } } } } while (0)

struct XcdBarrier {
    unsigned* bar; unsigned x;
    volatile LAS unsigned* st;
};

__device__ __forceinline__ XcdBarrier xcd_barrier_post(unsigned* bar, volatile LAS unsigned* st) {
    XcdBarrier b; b.bar = bar; b.x = xb_xcc_id(); b.st = st;
    if (threadIdx.x == 0) (void)xb_add(&bar[XB_XCNT(b.x)], 1u);
    return b;
}
__device__ __forceinline__ void xcd_barrier_complete(unsigned* bar, unsigned x, unsigned& nloc, unsigned& nx) {
    const unsigned G = gridDim.x * gridDim.y * gridDim.z;
    unsigned sum, cnt, mine, sp = 0u;
    for (;;) {
        sum = 0u; cnt = 0u; mine = 0u;
#pragma unroll
        for (unsigned j = 0; j < 16; ++j) { const unsigned c = xb_ld(&bar[XB_XCNT(j)]); sum += c; cnt += (c > 0u) ? 1u : 0u; mine = (j == x) ? c : mine; }
        if (sum == G) break;
        __builtin_amdgcn_s_sleep(1);
        if ((++sp & 255u) == 0u) { if (xb_ld(&bar[XB_TMO])) break; if (sp > XB_SPIN_CAP) { atomicAdd(&bar[XB_TMO], 1u); break; } }
    }
    nloc = mine > 0u ? mine : 1u; nx = cnt > 0u ? cnt : 1u;
}

__device__ __forceinline__ void xcd_barrier(const XcdBarrier& b) {
    asm volatile("s_waitcnt vmcnt(0)" ::: "memory");
    __syncthreads();
    if (threadIdx.x == 0) {
        unsigned* bar = b.bar;
        __builtin_amdgcn_s_waitcnt(0);
        unsigned nloc = b.st[0], nx = b.st[1];
        if (nloc == 0u) { xcd_barrier_complete(bar, b.x, nloc, nx); b.st[0] = nloc; b.st[1] = nx; }
        const unsigned old = xb_add(&bar[XB_XSUB(b.x)], 1u);
        const unsigned gen = old / nloc;
        if (old + 1u == (gen + 1u) * nloc) {
            __builtin_amdgcn_fence(__ATOMIC_RELEASE, "agent");
            asm volatile("s_waitcnt vmcnt(0)" ::: "memory");
            const unsigned og = xb_add(&bar[XB_TOP], 1u);
            const unsigned tg = og / nx;
            if (og + 1u == (tg + 1u) * nx) xb_add(&bar[XB_TOPGEN], 1u);
            else XB_SPIN(xb_ld(&bar[XB_TOPGEN]) == tg, bar);
            __builtin_amdgcn_fence(__ATOMIC_ACQUIRE, "agent");
            xb_add(&bar[XB_XGEN(b.x)], 1u);
            asm volatile("s_waitcnt vmcnt(0)" ::: "memory");
        } else {
            XB_SPIN(xb_ld(&bar[XB_XGEN(b.x)]) == gen, bar);
            __builtin_amdgcn_fence(__ATOMIC_ACQUIRE, "agent");
            asm volatile("s_waitcnt vmcnt(0)" ::: "memory");
        }
    }
    __syncthreads();
}

__device__ __forceinline__ int rowmap(int kind, int n) {
    if (kind == 0) return 256 * (n >> 7) + (n & 127);
    if (kind == 1) return 256 * (n >> 7) + 128 + (n & 127);
    if (kind == 3) return n < 1824 ? n : (n < 1836 ? PC_G + (n - 1824) : n - 12);
    return n;
}
struct TrDesc { const float* W; const float* gain; bf16_t* WT; int K, N, kind, k0, n0; };
__device__ __forceinline__ void tr_desc(const Args& a, int it, TrDesc& d) {
    constexpr int I_GU = 16 * 88, I_DN = 44 * 32, I_IN = 16 * 82, I_OUT = 16 * 32, I_C = 32 * 4;
    constexpr int I_LAYER = 4 * I_GU + 2 * I_DN + I_IN + I_OUT + 2 * I_C;
    const int l = it / I_LAYER; int r = it - l * I_LAYER;
    unsigned char* wb = a.ws + WS_W0 + (size_t)l * WS_LSTRIDE;
    const float* W; const float* gain = nullptr; bf16_t* WT; int K, N, kind;
    if (r < I_GU) { W = a.in[2] + (size_t)l * D * FF; K = D; N = FF; WT = (bf16_t*)(wb + WO_F1); kind = 0; gain = a.in[1] + l * D; }
    else if ((r -= I_GU) < I_GU) { W = a.in[3] + (size_t)l * D * FF; K = D; N = FF; WT = (bf16_t*)(wb + WO_F1); kind = 1; gain = a.in[1] + l * D; }
    else if ((r -= I_GU) < I_DN) { W = a.in[4] + (size_t)l * D * FF; K = FF; N = D; WT = (bf16_t*)(wb + WO_D1); kind = 2; }
    else if ((r -= I_DN) < I_GU) { W = a.in[30] + (size_t)l * D * FF; K = D; N = FF; WT = (bf16_t*)(wb + WO_F2); kind = 0; gain = a.in[29] + l * D; }
    else if ((r -= I_GU) < I_GU) { W = a.in[31] + (size_t)l * D * FF; K = D; N = FF; WT = (bf16_t*)(wb + WO_F2); kind = 1; gain = a.in[29] + l * D; }
    else if ((r -= I_GU) < I_DN) { W = a.in[32] + (size_t)l * D * FF; K = FF; N = D; WT = (bf16_t*)(wb + WO_D2); kind = 2; }
    else if ((r -= I_DN) < I_IN) { W = a.in[6] + (size_t)l * D * PT; K = D; N = PT; WT = (bf16_t*)(wb + WO_IN); kind = 3; gain = a.in[5] + l * D; }
    else if ((r -= I_IN) < I_OUT) { W = a.in[28] + (size_t)l * D * D; K = D; N = D; WT = (bf16_t*)(wb + WO_OUT); kind = 2; }
    else if ((r -= I_OUT) < I_C) { W = a.in[23] + (size_t)l * 2048 * 128; K = 2048; N = 128; WT = (bf16_t*)(wb + WO_CK); kind = 2; }
    else { r -= I_C; W = a.in[25] + (size_t)l * 2048 * 128; K = 2048; N = 128; WT = (bf16_t*)(wb + WO_CV); kind = 2; }
    const int nblk = (N + 31) >> 5, kb = r / nblk, nb = r - kb * nblk;
    d.W = W; d.gain = gain; d.WT = WT; d.K = K; d.N = N; d.kind = kind; d.k0 = 64 * kb; d.n0 = 32 * nb;
}
__device__ __forceinline__ void tr_load(const TrDesc& d, int lane, f32x4 (&v)[8]) {
    const int q4 = lane & 7, kr = lane >> 3, nn = d.n0 + 4 * q4, nc = nn < d.N ? nn : d.N - 4;
#pragma unroll
    for (int i = 0; i < 8; ++i) { const int kk = d.k0 + 8 * i + kr; f32x4 x = __builtin_nontemporal_load((const f32x4*)(d.W + (size_t)kk * d.N + nc));
        if (d.gain) x = x * d.gain[kk];
        if (nn >= d.N) x = (f32x4){0.f, 0.f, 0.f, 0.f};
        v[i] = x; }
}
__device__ __forceinline__ void tr_store(const TrDesc& d, int lane, const f32x4 (&v)[8], LAS float* scr) {
    { const int q4 = lane & 7, kr = lane >> 3;
#pragma unroll
      for (int i = 0; i < 8; ++i) { LAS float* p = scr + (8 * i + kr) * 33 + 4 * q4; p[0] = v[i][0]; p[1] = v[i][1]; p[2] = v[i][2]; p[3] = v[i][3]; } }
    LDS_WAIT();
    const int c = lane & 7;
#pragma unroll
    for (int j = 0; j < 4; ++j) { const int nl = (lane >> 3) + 8 * j, n = d.n0 + nl; const LAS float* s = scr + (8 * c) * 33 + nl;
        u32x4 o; o.x = pk2(s[0 * 33], s[1 * 33]); o.y = pk2(s[2 * 33], s[3 * 33]); o.z = pk2(s[4 * 33], s[5 * 33]); o.w = pk2(s[6 * 33], s[7 * 33]);
        if (n < d.N) *(u32x4*)(d.WT + (size_t)rowmap(d.kind, n) * d.K + d.k0 + 8 * c) = o; }
    LDS_WAIT();
}
__device__ __forceinline__ void prologue(const Args& a, LAS unsigned char* lds, int tid, int lane, int wave, int G, int bid, int rep) {
    LAS float* scr = (LAS float*)(lds + wave * 16384);
    const int gw = bid * 8 + wave, NGW = G * 8;
    if (bid == 0 && rep == 0 && tid < 64) ((unsigned*)(a.ws + WS_CTL))[tid * 64] = 0u;
    if (bid == 0 && tid < 33) ((const float**)(a.ws + WS_TAB))[tid] = a.in[tid];
    {
        constexpr int I_TOTAL = 2 * (4 * 16 * 88 + 2 * 44 * 32 + 16 * 82 + 16 * 32 + 2 * 32 * 4);
        TrDesc dc{}, dn{}; f32x4 vc[8] = {}, vn[8] = {};
        int it = gw;
        if (it < I_TOTAL) { tr_desc(a, it, dc); tr_load(dc, lane, vc); }
        while (it < I_TOTAL) {
            const int itn = it + NGW;
            if (itn < I_TOTAL) { tr_desc(a, itn, dn); tr_load(dn, lane, vn); }
            tr_store(dc, lane, vc, scr);
            dc = dn;
#pragma unroll
            for (int i = 0; i < 8; ++i) vc[i] = vn[i];
            it = itn;
        }
    }
    {
        const float* x = a.in[0]; bf16_t* XB = (bf16_t*)(a.ws + WS_XB); float* ssq = (float*)(a.ws + WS_SSQ);
#pragma unroll 4
        for (int m = gw; m < T; m += NGW) {
            const f32x4* xr = (const f32x4*)(x + (size_t)m * D) + 2 * lane; u32x4* brow = (u32x4*)(XB + (size_t)m * D) + lane;
#pragma unroll
            for (int j = 0; j < 2; ++j) { const f32x4 v0 = __builtin_nontemporal_load(xr + 128 * j), v1 = __builtin_nontemporal_load(xr + 128 * j + 1);
                u32x4 w; w.x = pk2(v0[0], v0[1]); w.y = pk2(v0[2], v0[3]); w.z = pk2(v1[0], v1[1]); w.w = pk2(v1[2], v1[3]); brow[64 * j] = w;
                float ss = ((v0[0] * v0[0] + v0[1] * v0[1]) + (v0[2] * v0[2] + v0[3] * v0[3])) + ((v1[0] * v1[0] + v1[1] * v1[1]) + (v1[2] * v1[2] + v1[3] * v1[3])); ss = red8(ss);
                if ((lane & 7) == 0) ssq[(size_t)m * 16 + 8 * j + (lane >> 3)] = ss; }
        }
    }
    for (int e = bid * 512 + tid; e < 2 * 73728; e += G * 512) {
        const int l = e / 73728; int r = e - l * 73728; bf16_t* img = (bf16_t*)(a.ws + WS_IMG + (size_t)l * IMG_LSTRIDE);
        if (r < 16384) { const int k = r >> 8, n = r & 255, np = ((n & ~63) + 16 * (2 * ((n & 63) >> 5) + ((n >> 2) & 1)) + 4 * ((n >> 3) & 3) + (n & 3)); img[IMG_RW / 2 + np * 72 + k] = (bf16_t)f2bf(a.in[11][l * 16384 + r]); continue; } r -= 16384;
        if (r < 8192) { const int k = r >> 8, n = r & 255, np = ((n & ~63) + 16 * (2 * ((n & 63) >> 5) + ((n >> 2) & 1)) + 4 * ((n >> 3) & 3) + (n & 3)); img[IMG_RW / 2 + 18432 + np * 40 + k] = (bf16_t)f2bf(a.in[13][l * 8192 + r]); continue; } r -= 8192;
        if (r < 16384) { const int k = r >> 8, n = r & 255, np = ((n & ~63) + 16 * (2 * ((n & 63) >> 5) + ((n >> 2) & 1)) + 4 * ((n >> 3) & 3) + (n & 3)); img[IMG_RW / 2 + 28672 + np * 72 + k] = (bf16_t)f2bf(a.in[14][l * 16384 + r]); continue; } r -= 16384;
        if (r < 16384) { const int g = r >> 12, c = (r >> 6) & 63, d = r & 63, dp = (d & 32) + 16 * ((d >> 2) & 1) + 4 * ((d >> 3) & 3) + (d & 3); img[IMG_POOL / 2 + (g * 64 + dp) * 72 + c] = (bf16_t)f2bf(a.in[7][l * 16384 + r]); continue; } r -= 16384;
        { const int kv = r >> 13, j = (r >> 6) & 127, d = r & 63; img[IMG_W2 / 2 + (kv * 64 + d) * 136 + j] = (bf16_t)f2bf((kv ? a.in[26] : a.in[24])[l * 8192 + (r & 8191)]); }
    }
    __syncthreads();
    for (int task = bid; task < 256; task += G) {
        const int l = task >> 7, kv = (task >> 6) & 1, part = task & 63;
        const float* pos = a.in[22] + l * 2048; const float* w1 = (kv ? a.in[25] : a.in[23]) + (size_t)l * 2048 * 128;
        const int j = tid & 127, sub = tid >> 7; float s = 0.f;
#pragma unroll
        for (int i = 0; i < 8; ++i) { const int ii = part * 32 + sub * 8 + i; s += pos[ii] * w1[(size_t)ii * 128 + j]; }
        LAS float* red = (LAS float*)lds;
        __syncthreads(); red[tid] = s; __syncthreads();
        if (tid < 128) ((float*)(a.ws + WS_CBP))[((l * 2 + kv) * 64 + part) * 128 + tid] = (red[tid] + red[tid + 128]) + (red[tid + 256] + red[tid + 384]);
    }
    __syncthreads();
}
__device__ __forceinline__ void pool_phase(const Args& a, int l, LAS unsigned char* lds, int tid, int lane, int wave, int G, int bid) {
    const bf16_t* P = (const bf16_t*)(a.ws + WS_P); bf16_t* Y = (bf16_t*)(a.ws + WS_Y);
    LAS bf16_t* U = (LAS bf16_t*)lds;
    LAS bf16_t* Dm = (LAS bf16_t*)(lds + 40960);
    LAS bf16_t* Wt = (LAS bf16_t*)(lds + 40960 + 33792);
    const float* pw = INTAB(a)[7] + l * 16384; const float* psc = INTAB(a)[8] + l * 256;
    { const u32x4* img = (const u32x4*)(a.ws + WS_IMG + (size_t)l * IMG_LSTRIDE + IMG_POOL); u32x4 r[5];
#pragma unroll
      for (int i = 0; i < 5; ++i) { const int q = tid + 512 * i; r[i] = img[q < 2304 ? q : 2303]; }
#pragma unroll
      for (int i = 0; i < 5; ++i) { const int q = tid + 512 * i; if (q < 2304) *(LAS u32x4*)((LAS unsigned char*)Wt + q * 16) = r[i]; } }
    for (int tile = bid; tile < T / 64; tile += G) {
        const int t0 = tile * 64, s0 = t0 & (SEQ - 1);
        __syncthreads();
        { u32x4 rr[5];
#pragma unroll
          for (int i = 0; i < 5; ++i) { const int pc = tid + 512 * i, r = pc >> 5, c8 = pc & 31, s = s0 - 16 + r; const int rowc = s >= 0 ? t0 - 16 + r : t0;
              rr[i] = *(const u32x4*)(P + (size_t)rowc * PLD + PC_A + c8 * 8); if (s < 0) rr[i] = (u32x4){0u, 0u, 0u, 0u}; }
#pragma unroll
          for (int i = 0; i < 5; ++i) { const int pc = tid + 512 * i, r = pc >> 5, c8 = pc & 31; *(LAS u32x4*)(U + r * 256 + c8 * 8) = rr[i]; } }
        __syncthreads();
        { const int c = tid & 255, half = tid >> 8, wlen = 2 << (c >> 6), tk0 = half * 32;
          float sum = 0.f;
          for (int jj = 1; jj < wlen; ++jj) sum += bf2f(U[(tk0 + 16 - jj) * 256 + c]);
#pragma unroll 8
          for (int tk = tk0; tk < tk0 + 32; ++tk) { const int r = tk + 16, s = s0 + tk, cnt = (s + 1 < wlen) ? s + 1 : wlen;
              const float cur = bf2f(U[r * 256 + c]), old = bf2f(U[(r - wlen + 1) * 256 + c]); sum += cur;
              Dm[tk * 264 + c] = (bf16_t)f2bf(sum * __builtin_amdgcn_rcpf((float)cnt) - cur); sum -= old; } }
        __syncthreads();
        { const int g = wave >> 1, n0 = (wave & 1) * 32;
            for (int mt = 0; mt < 4; ++mt) {
                const f32x4 z = (f32x4){0.f, 0.f, 0.f, 0.f};
                const f32x4 a0 = mma16(Dm + 16 * mt * 264 + g * 64, 264, Wt + (g * 64 + n0) * 72, 72, 64, lane, z), a1 = mma16(Dm + 16 * mt * 264 + g * 64, 264, Wt + (g * 64 + n0 + 16) * 72, 72, 64, lane, z);
                const int tok = 16 * mt + (lane & 15), col = g * 64 + n0 + 8 * (lane >> 4); const f32x4 s0v = *(const f32x4*)(psc + col), s1v = *(const f32x4*)(psc + col + 4);
                u32x4 w; w.x = pk2(a0[0] * s0v[0], a0[1] * s0v[1]); w.y = pk2(a0[2] * s0v[2], a0[3] * s0v[3]); w.z = pk2(a1[0] * s1v[0], a1[1] * s1v[1]); w.w = pk2(a1[2] * s1v[2], a1[3] * s1v[3]);
                *(u32x4*)(Y + (size_t)(t0 + tok) * D + col) = w; } }
    }
    __syncthreads();
}
__device__ __forceinline__ void unpack8(const u32x4 v, float (&f)[8]) {
    f[0] = bf_lo(v.x); f[1] = bf_hi(v.x); f[2] = bf_lo(v.y); f[3] = bf_hi(v.y); f[4] = bf_lo(v.z); f[5] = bf_hi(v.z); f[6] = bf_lo(v.w); f[7] = bf_hi(v.w);
}
__device__ __forceinline__ void conv_phase(const Args& a, int l, int tid, int G, int bid) {
    const bf16_t* __restrict__ P = (const bf16_t*)(a.ws + WS_P); bf16_t* __restrict__ Y = (bf16_t*)(a.ws + WS_Y);
    const float* __restrict__ cw = INTAB(a)[27] + l * 768;
    const int ch = (tid & 31) * 8;
    float w0[8], w1[8], w2[8];
#pragma unroll
    for (int e = 0; e < 8; ++e) { w0[e] = cw[ch + e]; w1[e] = cw[256 + ch + e]; w2[e] = cw[512 + ch + e]; }
#pragma unroll 4
    for (int t = bid * 16 + (tid >> 5); t < T; t += G * 16) {
        const int s = t & (SEQ - 1);
        const bf16_t* pr = P + (size_t)t * PLD;
        const u32x4 z4 = (u32x4){0u, 0u, 0u, 0u};
        const u32x4 u0 = *(const u32x4*)(pr + PC_U + ch), c0 = *(const u32x4*)(pr + PC_CC + ch), b0 = *(const u32x4*)(pr + PC_BB + ch);
        const bf16_t* pr1 = s >= 1 ? pr - PLD : pr; const bf16_t* pr2 = s >= 2 ? pr - 2 * PLD : pr;
        u32x4 u1 = *(const u32x4*)(pr1 + PC_U + ch), c1 = *(const u32x4*)(pr1 + PC_CC + ch), u2 = *(const u32x4*)(pr2 + PC_U + ch), c2 = *(const u32x4*)(pr2 + PC_CC + ch);
        if (s < 1) { u1 = z4; c1 = z4; } if (s < 2) { u2 = z4; c2 = z4; }
        float fu0[8], fc0[8], fb0[8], fu1[8], fc1[8], fu2[8], fc2[8], o[8];
        unpack8(u0, fu0); unpack8(c0, fc0); unpack8(b0, fb0); unpack8(u1, fu1); unpack8(c1, fc1); unpack8(u2, fu2); unpack8(c2, fc2);
#pragma unroll
        for (int e = 0; e < 8; ++e) o[e] = fb0[e] * (w0[e] * (fc2[e] * fu2[e]) + w1[e] * (fc1[e] * fu1[e]) + w2[e] * (fc0[e] * fu0[e]));
        u32x4 w; w.x = pk2(o[0], o[1]); w.y = pk2(o[2], o[3]); w.z = pk2(o[4], o[5]); w.w = pk2(o[6], o[7]);
        *(u32x4*)(Y + (size_t)t * D + 768 + ch) = w;
    }
}
__device__ __forceinline__ void rwkv_prep_phase(const Args& a, int l, LAS unsigned char* lds, int tid, int lane, int wave, int G, int bid) {
    const bf16_t* __restrict__ P = (const bf16_t*)(a.ws + WS_P);
    LAS bf16_t* WU = (LAS bf16_t*)lds;
    LAS bf16_t* AU = (LAS bf16_t*)(lds + 36864);
    LAS bf16_t* GU = (LAS bf16_t*)(lds + 57344);
    LAS bf16_t* Tw = (LAS bf16_t*)(lds + 94208);
    LAS bf16_t* Ta = (LAS bf16_t*)(lds + 103424);
    LAS bf16_t* Tg = (LAS bf16_t*)(lds + 108544);
    LAS float* WT7 = (LAS float*)(lds + 117760);
    const float* mu = INTAB(a)[9] + l * 928; const float* w0 = INTAB(a)[10] + l * 256; const float* wup = INTAB(a)[11] + l * 64 * 256; const float* a0 = INTAB(a)[12] + l * 256;
    const float* aup = INTAB(a)[13] + l * 32 * 256; const float* gup = INTAB(a)[14] + l * 64 * 256; const float* kkw = INTAB(a)[15] + l * 256; const float* kaw = INTAB(a)[16] + l * 256;
    bf16_t* __restrict__ Ro = (bf16_t*)(a.ws + WS_R); bf16_t* __restrict__ Ko = (bf16_t*)(a.ws + WS_K); bf16_t* __restrict__ Vo = (bf16_t*)(a.ws + WS_V); bf16_t* __restrict__ KKo = (bf16_t*)(a.ws + WS_KK);
    bf16_t* __restrict__ AKKo = (bf16_t*)(a.ws + WS_AKK); bf16_t* __restrict__ Go = (bf16_t*)(a.ws + WS_GG); float* __restrict__ DECo = (float*)(a.ws + WS_DEC);
    { const u32x4* img = (const u32x4*)(a.ws + WS_IMG + (size_t)l * IMG_LSTRIDE + IMG_RW); u32x4 r[12];
#pragma unroll
      for (int i = 0; i < 12; ++i) { const int q = tid + 512 * i; r[i] = img[q < 5888 ? q : 5887]; }
#pragma unroll
      for (int i = 0; i < 12; ++i) { const int q = tid + 512 * i; if (q < 5888) *(LAS u32x4*)(lds + q * 16) = r[i]; } }
    for (int e = tid; e < 7 * 256; e += 512) { const int v = e >> 8, c = e & 255; WT7[e] = v == 0 ? mu[c] : v == 1 ? mu[256 + c] : v == 2 ? mu[512 + c] : v == 3 ? w0[c] : v == 4 ? a0[c] : v == 5 ? kkw[c] : kaw[c]; }
    for (int tile = bid; tile < T / 64; tile += G) {
        const int t0 = tile * 64, s0 = t0 & (SEQ - 1);
        __syncthreads();
        { u32x4 cu[3], pv[3];
#pragma unroll
          for (int i = 0; i < 3; ++i) { int gi = tid + 512 * i; gi = gi < 1280 ? gi : 1279; const int tok = gi / 20, g8 = gi - tok * 20; const size_t t = (size_t)(t0 + tok);
              const bf16_t* pc = P + t * PLD + PC_B + 768 + g8 * 8; cu[i] = *(const u32x4*)pc; pv[i] = *(const u32x4*)((s0 + tok > 0) ? pc - PLD : pc); }
#pragma unroll
          for (int i = 0; i < 3; ++i) { const int gi = tid + 512 * i; if (gi < 1280) { const int tok = gi / 20, g8 = gi - tok * 20, j0 = g8 * 8; const bool hp = (s0 + tok) > 0;
              float fc[8], fp[8], ov[8]; unpack8(cu[i], fc); unpack8(pv[i], fp);
              const f32x4 m0 = *(const f32x4*)(mu + 768 + j0), m1 = *(const f32x4*)(mu + 768 + j0 + 4);
#pragma unroll
              for (int e = 0; e < 8; ++e) { const float pvv = hp ? fp[e] : 0.f; const float val = fc[e] + (e < 4 ? m0[e & 3] : m1[e & 3]) * (pvv - fc[e]);
                  const float sg = sigmoidf_(j0 < 64 ? 2.0f * val : val); ov[e] = j0 < 64 ? 2.0f * sg - 1.0f : (j0 < 96 ? val : sg); }
              u32x4 w; w.x = pk2(ov[0], ov[1]); w.y = pk2(ov[2], ov[3]); w.z = pk2(ov[4], ov[5]); w.w = pk2(ov[6], ov[7]);
              LAS bf16_t* dst = j0 < 64 ? Tw + tok * 72 + j0 : (j0 < 96 ? Ta + tok * 40 + (j0 - 64) : Tg + tok * 72 + (j0 - 96));
              *(LAS u32x4*)dst = w; } } }
        __syncthreads();
#pragma unroll 1
        for (int x = 0; x < 2; ++x) { const int task = wave * 2 + x, mt = task >> 2, h = task & 3;
            const int tok = 16 * mt + (lane & 15), t = t0 + tok, fq = lane >> 4; const bool hasprev = (s0 + tok) > 0;
            float kkr[2][8], av[2][8]; float ss = 0.f;
            u32x4 prc[2][3], prp_[2][3];
            { const bf16_t* pr0 = P + (size_t)t * PLD + PC_B + h * 64 + 8 * fq; const bf16_t* pp0 = hasprev ? pr0 - PLD : pr0;
#pragma unroll
              for (int pp = 0; pp < 2; ++pp)
#pragma unroll
                  for (int q = 0; q < 3; ++q) { prc[pp][q] = *(const u32x4*)(pr0 + pp * 32 + q * 256); prp_[pp][q] = *(const u32x4*)(pp0 + pp * 32 + q * 256); } }
#pragma unroll
            for (int pp = 0; pp < 2; ++pp) { const int n0 = h * 64 + pp * 32, col = n0 + 8 * fq; const f32x4 z = (f32x4){0.f, 0.f, 0.f, 0.f};
                const f32x4 aw0 = mma16(Tw + 16 * mt * 72, 72, WU + n0 * 72, 72, 64, lane, z), aw1 = mma16(Tw + 16 * mt * 72, 72, WU + (n0 + 16) * 72, 72, 64, lane, z);
                const f32x4 aa0 = mma16(Ta + 16 * mt * 40, 40, AU + n0 * 40, 40, 32, lane, z), aa1 = mma16(Ta + 16 * mt * 40, 40, AU + (n0 + 16) * 40, 40, 32, lane, z);
                const f32x4 ag0 = mma16(Tg + 16 * mt * 72, 72, GU + n0 * 72, 72, 64, lane, z), ag1 = mma16(Tg + 16 * mt * 72, 72, GU + (n0 + 16) * 72, 72, 64, lane, z);
                float rc[8], kc[8], vc[8], rp[8], kp[8], vp[8];
                unpack8(prc[pp][0], rc); unpack8(prc[pp][1], kc); unpack8(prc[pp][2], vc); unpack8(prp_[pp][0], rp); unpack8(prp_[pp][1], kp); unpack8(prp_[pp][2], vp);
                float r8[8], k8[8], v8[8], g8[8], d8[8];
#pragma unroll
                for (int e = 0; e < 8; ++e) {
                    const int c = col + e;
                    const float rprev = hasprev ? rp[e] : 0.f, kprev = hasprev ? kp[e] : 0.f, vprev = hasprev ? vp[e] : 0.f;
                    r8[e] = rc[e] + WT7[c] * (rprev - rc[e]);
                    const float kraw = kc[e] + WT7[256 + c] * (kprev - kc[e]);
                    v8[e] = vc[e] + WT7[512 + c] * (vprev - vc[e]);
                    const float accw = e < 4 ? aw0[e & 3] : aw1[e & 3], acca = e < 4 ? aa0[e & 3] : aa1[e & 3], accg = e < 4 ? ag0[e & 3] : ag1[e & 3];
                    const float wv = WT7[768 + c] + accw; d8[e] = __expf(-0.6065306597126334f * sigmoidf_(wv));
                    const float aa = sigmoidf_(WT7[1024 + c] + acca); av[pp][e] = aa; g8[e] = accg;
                    const float kq = kraw * WT7[1280 + c]; kkr[pp][e] = kq; ss += kq * kq;
                    k8[e] = kraw * (1.0f + (aa - 1.0f) * WT7[1536 + c]);
                }
                const size_t o = (size_t)t * 256 + col;
                u32x4 w; w.x = pk2(r8[0], r8[1]); w.y = pk2(r8[2], r8[3]); w.z = pk2(r8[4], r8[5]); w.w = pk2(r8[6], r8[7]); *(u32x4*)(Ro + o) = w;
                w.x = pk2(k8[0], k8[1]); w.y = pk2(k8[2], k8[3]); w.z = pk2(k8[4], k8[5]); w.w = pk2(k8[6], k8[7]); *(u32x4*)(Ko + o) = w;
                w.x = pk2(v8[0], v8[1]); w.y = pk2(v8[2], v8[3]); w.z = pk2(v8[4], v8[5]); w.w = pk2(v8[6], v8[7]); *(u32x4*)(Vo + o) = w;
                w.x = pk2(g8[0], g8[1]); w.y = pk2(g8[2], g8[3]); w.z = pk2(g8[4], g8[5]); w.w = pk2(g8[6], g8[7]); *(u32x4*)(Go + o) = w;
                *(f32x4*)(DECo + o) = (f32x4){d8[0], d8[1], d8[2], d8[3]}; *(f32x4*)(DECo + o + 4) = (f32x4){d8[4], d8[5], d8[6], d8[7]};
            }
            ss += __shfl_xor(ss, 16); ss += __shfl_xor(ss, 32);
            const float inv = rsqrtf(fmaxf(ss, 1e-24f));
#pragma unroll
            for (int pp = 0; pp < 2; ++pp) { const size_t o = (size_t)t * 256 + h * 64 + pp * 32 + 8 * fq;
                float q[8], qa[8];
#pragma unroll
                for (int e = 0; e < 8; ++e) { q[e] = kkr[pp][e] * inv; qa[e] = q[e] * av[pp][e]; }
                u32x4 w; w.x = pk2(q[0], q[1]); w.y = pk2(q[2], q[3]); w.z = pk2(q[4], q[5]); w.w = pk2(q[6], q[7]); *(u32x4*)(KKo + o) = w;
                w.x = pk2(qa[0], qa[1]); w.y = pk2(qa[2], qa[3]); w.z = pk2(qa[4], qa[5]); w.w = pk2(qa[6], qa[7]); *(u32x4*)(AKKo + o) = w; }
        }
    }
    __syncthreads();
}
__device__ __forceinline__ void nsa_prep_phase(const Args& a, int l, int tid, int G, int bid) {
    const bf16_t* __restrict__ P = (const bf16_t*)(a.ws + WS_P);
    const float* __restrict__ qw = INTAB(a)[20] + l * 64; const float* __restrict__ kw = INTAB(a)[21] + l * 192;
    bf16_t* __restrict__ QN = (bf16_t*)(a.ws + WS_QN); bf16_t* __restrict__ KSEL = (bf16_t*)(a.ws + WS_KSEL); bf16_t* __restrict__ VSEL = (bf16_t*)(a.ws + WS_VSEL); bf16_t* __restrict__ KWIN = (bf16_t*)(a.ws + WS_KWIN); bf16_t* __restrict__ VWIN = (bf16_t*)(a.ws + WS_VWIN);
    float* __restrict__ GATES = (float*)(a.ws + WS_GATES);
    const int sub = tid & 7, vi = (tid >> 3) & 7;
    const int scol = vi < 4 ? PC_Q + vi * 64 : (vi == 4 ? PC_KS : (vi == 5 ? PC_KW : (vi == 6 ? PC_VS : PC_VW)));
    const float* nwp = vi < 4 ? qw : (vi == 4 ? kw + 64 : kw + 128);
    const f32x4 nw0 = *(const f32x4*)(nwp + sub * 8), nw1 = *(const f32x4*)(nwp + sub * 8 + 4);
    bf16_t* dbase = vi < 4 ? QN + vi * 64 : (vi == 4 ? KSEL : (vi == 5 ? KWIN : (vi == 6 ? VSEL : VWIN)));
    const int dstride = vi < 4 ? 256 : 64;
    const float qsc = vi < 4 ? (0.125f * 1.4426950408889634f) : 1.0f;
#pragma unroll 4
    for (int t = bid * 8 + (tid >> 6); t < T; t += G * 8) {
        const u32x4 v = *(const u32x4*)(P + (size_t)t * PLD + scol + sub * 8);
        float f[8]; unpack8(v, f);
        float ss = ((f[0] * f[0] + f[1] * f[1]) + (f[2] * f[2] + f[3] * f[3])) + ((f[4] * f[4] + f[5] * f[5]) + (f[6] * f[6] + f[7] * f[7])); ss = red8(ss);
        const float sc = qsc * rsqrtf(ss * (1.0f / 64.0f) + 1e-6f);
        u32x4 w = v;
        if (vi < 6) { w.x = pk2(f[0] * sc * nw0[0], f[1] * sc * nw0[1]); w.y = pk2(f[2] * sc * nw0[2], f[3] * sc * nw0[3]); w.z = pk2(f[4] * sc * nw1[0], f[5] * sc * nw1[1]); w.w = pk2(f[6] * sc * nw1[2], f[7] * sc * nw1[3]); }
        *(u32x4*)(dbase + (size_t)t * dstride + sub * 8) = w;
    }
#pragma unroll 3
    for (int e = bid * 512 + tid; e < T * 12; e += G * 512) { const int t = e / 12, j = e - t * 12; GATES[e] = sigmoidf_(bf2f(P[(size_t)t * PLD + PC_G + j])); }
}
__device__ __forceinline__ float gelu_tanh(float x) { const float u = 0.7978845608028654f * (x + 0.044715f * x * x * x); return 0.5f * x * (1.0f + tanhf(u)); }
__device__ __forceinline__ void compress_phase(const Args& a, int l, LAS unsigned char* lds, int tid, int lane, int wave, int G, int bid) {
    const bf16_t* P = (const bf16_t*)(a.ws + WS_P);
    LAS bf16_t* KC = (LAS bf16_t*)lds;
    LAS bf16_t* VC = (LAS bf16_t*)(lds + 39168);
    LAS bf16_t* HK = (LAS bf16_t*)(lds + 78336);
    LAS bf16_t* W2 = (LAS bf16_t*)(lds + 87040);
    LAS float* OK = (LAS float*)(lds + 121856);
    LAS float* BI = (LAS float*)(lds + 125952);
    const bf16_t* WCK = (const bf16_t*)(a.ws + WS_W0 + (size_t)l * WS_LSTRIDE + WO_CK); const bf16_t* WCV = (const bf16_t*)(a.ws + WS_W0 + (size_t)l * WS_LSTRIDE + WO_CV);
    bf16_t* KCMP = (bf16_t*)(a.ws + WS_KCMP); bf16_t* VCMP = (bf16_t*)(a.ws + WS_VCMP);
    const float* knw = INTAB(a)[21] + l * 192;
    { const u32x4* img = (const u32x4*)(a.ws + WS_IMG + (size_t)l * IMG_LSTRIDE + IMG_W2); u32x4 r[5];
#pragma unroll
      for (int i = 0; i < 5; ++i) { const int q = tid + 512 * i; r[i] = img[q < 2176 ? q : 2175]; }
#pragma unroll
      for (int i = 0; i < 5; ++i) { const int q = tid + 512 * i; if (q < 2176) *(LAS u32x4*)((LAS unsigned char*)W2 + q * 16) = r[i]; } }
    if (tid < 256) { const int kv = tid >> 7, j = tid & 127; const float* cb = (const float*)(a.ws + WS_CBP) + ((l * 2 + kv) * 64) * 128 + j; float s = 0.f;
#pragma unroll 16
        for (int p = 0; p < 64; ++p) s += cb[p * 128]; BI[tid] = s; }
    for (int unit = bid; unit < 256; unit += G) {
        const int b = unit >> 5, grp = (unit >> 1) & 15, kv = unit & 1, sbase = 256 * grp;
        __syncthreads();
        { u32x4 rr[5];
#pragma unroll
          for (int i = 0; i < 5; ++i) { int pc = tid + 512 * i; pc = pc < 2176 ? pc : 2175; const int r = pc >> 3, c8 = pc & 7, sx = sbase + r; const int sc_ = sx < SEQ ? sx : SEQ - 1;
              rr[i] = *(const u32x4*)(P + (size_t)(b * SEQ + sc_) * PLD + (kv ? PC_VC : PC_KC) + c8 * 8); if (sx >= SEQ) rr[i] = (u32x4){0u, 0u, 0u, 0u}; }
#pragma unroll
          for (int i = 0; i < 5; ++i) { const int pc = tid + 512 * i; if (pc < 2176) { const int r = pc >> 3, c8 = pc & 7; *(LAS u32x4*)(KC + r * 72 + c8 * 8) = rr[i]; } } }
        __syncthreads();
        { const int nt = wave;
            const LAS bf16_t* ap = KC + 16 * (lane & 15) * 72 + 8 * (lane >> 4);
            const bf16_t* bp = (kv ? WCV : WCK) + (size_t)(nt * 16 + (lane & 15)) * 2048 + 8 * (lane >> 4);
            f32x4 acc = (f32x4){0.f, 0.f, 0.f, 0.f};
#pragma unroll 16
            for (int j = 0; j < 32; ++j) {
                const bf16x8 a0 = *(const LAS bf16x8*)(ap + j * 72), a1 = *(const LAS bf16x8*)(ap + j * 72 + 32);
                const bf16x8 b0 = *(const bf16x8*)(bp + j * 64), b1 = *(const bf16x8*)(bp + j * 64 + 32);
                acc = __builtin_amdgcn_mfma_f32_16x16x32_bf16(b0, a0, acc, 0, 0, 0);
                acc = __builtin_amdgcn_mfma_f32_16x16x32_bf16(b1, a1, acc, 0, 0, 0);
            }
            const int m = lane & 15, col = nt * 16 + 4 * (lane >> 4);
            float hv[4];
#pragma unroll
            for (int i = 0; i < 4; ++i) hv[i] = gelu_tanh(acc[i] + BI[kv * 128 + col + i]);
            u32x2 w; w.x = pk2(hv[0], hv[1]); w.y = pk2(hv[2], hv[3]);
            *(LAS u32x2*)(HK + m * 136 + col) = w;
        }
        __syncthreads();
        if (wave < 4) { const int nt2 = wave;
          const f32x4 acc = mma16(HK, 136, W2 + (kv * 64 + nt2 * 16) * 136, 136, 128, lane, (f32x4){0.f, 0.f, 0.f, 0.f});
          const int m = lane & 15, d0 = nt2 * 16 + 4 * (lane >> 4), n = 16 * grp + m;
          if (kv == 1) { u32x2 w; w.x = pk2(acc[0], acc[1]); w.y = pk2(acc[2], acc[3]); *(u32x2*)(VCMP + (size_t)(b * 256 + n) * 64 + d0) = w; }
          else *(LAS f32x4*)(OK + m * 64 + d0) = acc; }
        __syncthreads();
        if (kv == 0 && tid < 256) { const int m = tid >> 4, sub = tid & 15; const f32x4 v = *(const LAS f32x4*)(OK + m * 64 + sub * 4);
            float ss = (v[0] * v[0] + v[1] * v[1]) + (v[2] * v[2] + v[3] * v[3]); ss = red16(ss);
            const float rs = rsqrtf(ss * (1.0f / 64.0f) + 1e-6f); const float* nw = knw + sub * 4;
            u32x2 w; w.x = pk2(v[0] * rs * nw[0], v[1] * rs * nw[1]); w.y = pk2(v[2] * rs * nw[2], v[3] * rs * nw[3]);
            *(u32x2*)(KCMP + (size_t)(b * 256 + 16 * grp + m) * 64 + sub * 4) = w; }
    }
    __syncthreads();
}
constexpr int SC_CH = 32, SC_STEP = 336;
__device__ __forceinline__ void scan_phase(const Args& a, LAS unsigned char* lds, int tid, int lane, int wave, int G, int bid) {
    LAS float* OP = (LAS float*)lds;
    LAS float* YB = (LAS float*)(lds + 2 * SC_CH * SC_STEP * 4);
    const bf16_t* Rr = (const bf16_t*)(a.ws + WS_R); const bf16_t* Kr = (const bf16_t*)(a.ws + WS_K); const bf16_t* Vr = (const bf16_t*)(a.ws + WS_V);
    const bf16_t* KKr = (const bf16_t*)(a.ws + WS_KK); const bf16_t* AKKr = (const bf16_t*)(a.ws + WS_AKK); const float* DECr = (const float*)(a.ws + WS_DEC);
    float* YR = (float*)(a.ws + WS_YR);
    for (int unit = bid; unit < 128; unit += G) {
        const int b = unit >> 4, h = (unit >> 2) & 3, v0 = (unit & 3) * 16;
        const size_t tb = (size_t)b * SEQ;
        const int pst = (tid & 255) >> 3, pg8 = tid & 7, dst_ = tid >> 4, dg4 = tid & 15, vst = (tid & 63) >> 1, vhalf = tid & 1;
        const bf16_t* srcA = ((tid & 256) ? AKKr : KKr) + (tb + pst) * 256 + h * 64 + pg8 * 8;
        const bf16_t* srcB = ((tid & 256) ? Rr : Kr) + (tb + pst) * 256 + h * 64 + pg8 * 8;
        const float* srcD = DECr + (tb + dst_) * 256 + h * 64 + dg4 * 4;
        const bf16_t* srcV = Vr + (tb + vst) * 256 + h * 64 + v0 + vhalf * 8;
        const int ldA = pst * SC_STEP + ((tid & 256) ? 64 : 0) + pg8 * 8, ldB = pst * SC_STEP + ((tid & 256) ? 256 : 192) + pg8 * 8, ldD = dst_ * SC_STEP + 128 + dg4 * 4, ldV = vst * SC_STEP + 320 + vhalf * 8;
        u32x4 rA, rB, rV = (u32x4){0u, 0u, 0u, 0u}; f32x4 rD;
#define SCAN_ISSUE(CH) do { const size_t co = (size_t)(CH) * SC_CH * 256; rA = *(const u32x4*)(srcA + co); rB = *(const u32x4*)(srcB + co); rD = *(const f32x4*)(srcD + co); if (tid < 64) rV = *(const u32x4*)(srcV + co); } while (0)
#define SCAN_PUT8(dst, v) do { *(LAS f32x4*)(dst) = (f32x4){bf_lo((v).x), bf_hi((v).x), bf_lo((v).y), bf_hi((v).y)}; *(LAS f32x4*)((dst) + 4) = (f32x4){bf_lo((v).z), bf_hi((v).z), bf_lo((v).w), bf_hi((v).w)}; } while (0)
        typedef float f32x2 __attribute__((ext_vector_type(2)));
        f32x2 Sa = (f32x2){0.f, 0.f}, Sb = (f32x2){0.f, 0.f};
        const int lr = lane >> 4, c = lane & 15, row = 4 * wave + lr;
        SCAN_ISSUE(0);
        __syncthreads();
        for (int ch = 0; ch < SEQ / SC_CH; ++ch) {
            LAS float* buf = OP + (ch & 1) * SC_CH * SC_STEP;
            SCAN_PUT8(buf + ldA, rA); SCAN_PUT8(buf + ldB, rB); *(LAS f32x4*)(buf + ldD) = rD; if (tid < 64) SCAN_PUT8(buf + ldV, rV);
            __syncthreads();
            if (ch + 1 < SEQ / SC_CH) SCAN_ISSUE(ch + 1);
            if (wave < 4) {
                float yk = 0.f;
                const LAS float* op0 = buf + 4 * c; const LAS float* ov0 = buf + 320 + row;
                f32x4 nkk = *(const LAS f32x4*)(op0), nak = *(const LAS f32x4*)(op0 + 64), nw = *(const LAS f32x4*)(op0 + 128), nk = *(const LAS f32x4*)(op0 + 192), nr = *(const LAS f32x4*)(op0 + 256); float nvv = ov0[0];
#pragma unroll 1
                for (int og = 0; og < 4; ++og) {
                    const LAS float* opb = op0 + og * 8 * SC_STEP; const LAS float* ovb = ov0 + og * 8 * SC_STEP;
                    const int cm = c - 8 * (og & 1);
#pragma unroll
                    for (int i = 0; i < 8; ++i) {
                        const f32x4 kk4 = nkk, ak4 = nak, w4 = nw, k4 = nk, r4 = nr; const float vv = nvv;
                        { const int nx = (i < 7) ? (i + 1) : (og < 3 ? 8 : 7); const LAS float* on = opb + nx * SC_STEP;
                          nkk = *(const LAS f32x4*)(on); nak = *(const LAS f32x4*)(on + 64); nw = *(const LAS f32x4*)(on + 128); nk = *(const LAS f32x4*)(on + 192); nr = *(const LAS f32x4*)(on + 256); nvv = ovb[nx * SC_STEP]; }
                        f32x2 t = Sa * (f32x2){kk4[0], kk4[1]}; t = __builtin_elementwise_fma(Sb, (f32x2){kk4[2], kk4[3]}, t);
                        float sa = t.x + t.y;
                        sa = allred16_dpp(sa);
                        const f32x2 nsa2 = (f32x2){-sa, -sa}, vv2 = (f32x2){vv, vv};
                        f32x2 ua = vv2 * (f32x2){k4[0], k4[1]}, ub = vv2 * (f32x2){k4[2], k4[3]};
                        ua = __builtin_elementwise_fma(nsa2, (f32x2){ak4[0], ak4[1]}, ua); ub = __builtin_elementwise_fma(nsa2, (f32x2){ak4[2], ak4[3]}, ub);
                        Sa = __builtin_elementwise_fma(Sa, (f32x2){w4[0], w4[1]}, ua); Sb = __builtin_elementwise_fma(Sb, (f32x2){w4[2], w4[3]}, ub);
                        f32x2 yy = Sa * (f32x2){r4[0], r4[1]}; yy = __builtin_elementwise_fma(Sb, (f32x2){r4[2], r4[3]}, yy);
                        float y = yy.x + yy.y;
                        y = allred16_dpp(y);
                        yk = (cm == i) ? y : yk;
                    }
                    if (og & 1) YB[((og >> 1) * 16 + c) * 16 + row] = yk;
                }
            }
            __syncthreads();
            { const int st = tid >> 4, r = tid & 15; YR[(tb + ch * SC_CH + st) * 256 + h * 64 + v0 + r] = YB[st * 16 + r]; }
        }
        __syncthreads();
    }
}
__device__ __forceinline__ void rwkv_out_phase(const Args& a, int l, int tid, int G, int bid) {
    const float* __restrict__ YR = (const float*)(a.ws + WS_YR); bf16_t* __restrict__ Y = (bf16_t*)(a.ws + WS_Y);
    const bf16_t* __restrict__ Rr = (const bf16_t*)(a.ws + WS_R); const bf16_t* __restrict__ Kr = (const bf16_t*)(a.ws + WS_K); const bf16_t* __restrict__ Vr = (const bf16_t*)(a.ws + WS_V); const bf16_t* __restrict__ Gr = (const bf16_t*)(a.ws + WS_GG);
    const float* rk = INTAB(a)[17] + l * 256; const float* lw = INTAB(a)[18] + l * 256; const float* lb = INTAB(a)[19] + l * 256;
    const int sub = tid & 7, c0 = ((tid >> 3) & 3) * 64 + sub * 8;
    const f32x4 rk0 = *(const f32x4*)(rk + c0), rk1 = *(const f32x4*)(rk + c0 + 4), lw0 = *(const f32x4*)(lw + c0), lw1 = *(const f32x4*)(lw + c0 + 4), lb0 = *(const f32x4*)(lb + c0), lb1 = *(const f32x4*)(lb + c0 + 4);
#pragma unroll 4
    for (int t = bid * 16 + (tid >> 5); t < T; t += G * 16) {
        const size_t o = (size_t)t * 256 + c0;
        const f32x4 y0 = *(const f32x4*)(YR + o), y1 = *(const f32x4*)(YR + o + 4);
        const u32x4 r4 = *(const u32x4*)(Rr + o), k4 = *(const u32x4*)(Kr + o), v4 = *(const u32x4*)(Vr + o), g4 = *(const u32x4*)(Gr + o);
        const float mean = red8(((y0[0] + y0[1]) + (y0[2] + y0[3])) + ((y1[0] + y1[1]) + (y1[2] + y1[3]))) * (1.0f / 64.0f);
        const f32x4 d0 = y0 - mean, d1 = y1 - mean;
        const float var = red8(((d0[0] * d0[0] + d0[1] * d0[1]) + (d0[2] * d0[2] + d0[3] * d0[3])) + ((d1[0] * d1[0] + d1[1] * d1[1]) + (d1[2] * d1[2] + d1[3] * d1[3]))) * (1.0f / 64.0f);
        const float rstd = rsqrtf(var + 64e-5f);
        float r[8], k[8], v[8], g[8]; unpack8(r4, r); unpack8(k4, k); unpack8(v4, v); unpack8(g4, g);
        float bs = 0.f;
#pragma unroll
        for (int i = 0; i < 8; ++i) bs += r[i] * k[i] * (i < 4 ? rk0[i & 3] : rk1[i & 3]);
        bs = red8(bs);
        float ov[8];
#pragma unroll
        for (int i = 0; i < 8; ++i) { const float dd = i < 4 ? d0[i & 3] : d1[i & 3], lwv = i < 4 ? lw0[i & 3] : lw1[i & 3], lbv = i < 4 ? lb0[i & 3] : lb1[i & 3]; ov[i] = (dd * rstd * lwv + lbv + bs * v[i]) * g[i]; }
        u32x4 w; w.x = pk2(ov[0], ov[1]); w.y = pk2(ov[2], ov[3]); w.z = pk2(ov[4], ov[5]); w.w = pk2(ov[6], ov[7]);
        *(u32x4*)(Y + (size_t)t * D + 256 + c0) = w;
    }
}
constexpr float LOG2E = 1.4426950408889634f;
constexpr int NSA_KV = 64 * 72, NSA_VS = 76, NSA_BUF = NSA_KV + 64 * NSA_VS;
template <int MODE>
__device__ __forceinline__ void attn_tiles(unsigned long long tmask, const bf16_t* __restrict__ Ksrc, const bf16_t* __restrict__ Vsrc, LAS bf16_t* KVB, LAS float* IMPh,
                                           const bf16x8 (&qf)[2][2], float (&lrow)[2], f32x4 (&o)[2][4], const unsigned long long (&selm)[2],
                                           int qi, int qbase, float slope2, float bnd, int tid, int lane, int wave) {
    const int fr = lane & 15, fq = lane >> 4;
    const int key = tid >> 3, part = tid & 7;
    if (!tmask) return;
    const u32x4 zz = (u32x4){0u, 0u, 0u, 0u};
    u32x4 k0 = zz, v0 = zz, k1 = zz, v1 = zz;
    unsigned long long lm = tmask;
#define NSA_LOAD(KR, VR) do { const int j_ = __builtin_ctzll(lm); lm &= lm - 1; KR = *(const u32x4*)(Ksrc + (size_t)(64 * j_ + key) * 64 + part * 8); VR = *(const u32x4*)(Vsrc + (size_t)(64 * j_ + key) * 64 + part * 8); } while (0)
#define NSA_PUT(BUF) do { LAS bf16_t* kt_ = KVB + (BUF) * NSA_BUF; *(LAS u32x4*)(kt_ + key * 72 + part * 8) = k0; LAS bf16_t* vp = kt_ + NSA_KV + (part * 8) * NSA_VS + key; \
        vp[0 * NSA_VS] = (bf16_t)(v0.x & 0xffffu); vp[1 * NSA_VS] = (bf16_t)(v0.x >> 16); vp[2 * NSA_VS] = (bf16_t)(v0.y & 0xffffu); vp[3 * NSA_VS] = (bf16_t)(v0.y >> 16); \
        vp[4 * NSA_VS] = (bf16_t)(v0.z & 0xffffu); vp[5 * NSA_VS] = (bf16_t)(v0.z >> 16); vp[6 * NSA_VS] = (bf16_t)(v0.w & 0xffffu); vp[7 * NSA_VS] = (bf16_t)(v0.w >> 16); } while (0)
    NSA_LOAD(k0, v0);
    if (lm) NSA_LOAD(k1, v1);
    __syncthreads();
    NSA_PUT(0); k0 = k1; v0 = v1;
    if (lm) NSA_LOAD(k1, v1);
    __syncthreads();
    int cur = 0;
    for (;;) {
        const int j = __builtin_ctzll(tmask); tmask &= tmask - 1;
        if (tmask) { NSA_PUT(cur ^ 1); k0 = k1; v0 = v1; if (lm) NSA_LOAD(k1, v1); }
        const LAS bf16_t* KT = KVB + cur * NSA_BUF; const LAS bf16_t* VT = KT + NSA_KV;
        constexpr int DM = (MODE == 1) ? 16 : 1;
        const float sl = slope2 * (float)DM;
        int dbase[2]; float c0[2];
#pragma unroll
        for (int mt = 0; mt < 2; ++mt) { const int sq = 64 * qi + qbase + 16 * mt + fr;
            dbase[mt] = (MODE == 1) ? sq - 31 - 1024 * j - 64 * fq : sq - 64 * j - 4 * fq;
            c0[mt] = -slope2 * (float)dbase[mt] - bnd;
            if (MODE == 2) { if (((selm[mt] >> j) & 1ull) == 0ull) c0[mt] = -1e30f; } }
        f32x4 st[2][4];
#pragma unroll
        for (int nt = 0; nt < 4; ++nt) {
            const bf16x8 k0 = *(const LAS bf16x8*)(KT + (16 * nt + fr) * 72 + 8 * fq), k1 = *(const LAS bf16x8*)(KT + (16 * nt + fr) * 72 + 32 + 8 * fq);
#pragma unroll
            for (int mt = 0; mt < 2; ++mt) {
                const f32x4 ini = (f32x4){fmaf(sl, (float)(16 * nt), c0[mt]), fmaf(sl, (float)(16 * nt + 1), c0[mt]), fmaf(sl, (float)(16 * nt + 2), c0[mt]), fmaf(sl, (float)(16 * nt + 3), c0[mt])};
                f32x4 s = __builtin_amdgcn_mfma_f32_16x16x32_bf16(k0, qf[mt][0], ini, 0, 0, 0);
                st[mt][nt] = __builtin_amdgcn_mfma_f32_16x16x32_bf16(k1, qf[mt][1], s, 0, 0, 0);
            }
        }
        const bool boundary = (MODE == 1) || (j == qi) || (MODE == 3 && j == qi - 8);
#pragma unroll
        for (int mt = 0; mt < 2; ++mt) {
            float ls = 0.f;
            if (boundary) {
#pragma unroll
                for (int nt = 0; nt < 4; ++nt)
#pragma unroll
                    for (int i = 0; i < 4; ++i) { const int dist = dbase[mt] - DM * (16 * nt + i);
                        bool valid = dist >= 0; if (MODE == 3) valid = valid && (dist < 512);
                        const float p = valid ? __builtin_amdgcn_exp2f(st[mt][nt][i]) : 0.f; st[mt][nt][i] = p; ls += p; }
            } else {
#pragma unroll
                for (int nt = 0; nt < 4; ++nt)
#pragma unroll
                    for (int i = 0; i < 4; ++i) { const float p = __builtin_amdgcn_exp2f(st[mt][nt][i]); st[mt][nt][i] = p; ls += p; }
            }
            lrow[mt] += ls;
            if (MODE == 1) {
                LAS float* ir = IMPh + (qbase + 16 * mt + fr) * 65;
#pragma unroll
                for (int nt = 0; nt < 4; ++nt) { const int jj = 16 * j + 4 * nt + fq; const f32x4 p = st[mt][nt];
                    const float c1 = (p[0] + p[1]) + (p[2] + p[3]), c2 = p[3];
                    if (c1 != 0.f) { atomicAdd((float*)(ir + jj), c1); if (jj + 1 < 64 && c2 != 0.f) atomicAdd((float*)(ir + jj + 1), c2); } }
            }
        }
#pragma unroll
        for (int ks = 0; ks < 2; ++ks) {
            bf16x8 pb[2];
#pragma unroll
            for (int mt = 0; mt < 2; ++mt) { u32x4 w; const f32x4 pa = st[mt][2 * ks], pc = st[mt][2 * ks + 1];
                w.x = pk2(pa[0], pa[1]); w.y = pk2(pa[2], pa[3]); w.z = pk2(pc[0], pc[1]); w.w = pk2(pc[2], pc[3]); pb[mt] = __builtin_bit_cast(bf16x8, w); }
#pragma unroll
            for (int dt = 0; dt < 4; ++dt) {
                const u32x2 lo = *(const LAS u32x2*)(VT + (16 * dt + fr) * NSA_VS + 32 * ks + 4 * fq), hi = *(const LAS u32x2*)(VT + (16 * dt + fr) * NSA_VS + 32 * ks + 16 + 4 * fq);
                const bf16x8 vf = __builtin_bit_cast(bf16x8, ((u32x4){lo.x, lo.y, hi.x, hi.y}));
#pragma unroll
                for (int mt = 0; mt < 2; ++mt) o[mt][dt] = __builtin_amdgcn_mfma_f32_16x16x32_bf16(vf, pb[mt], o[mt][dt], 0, 0, 0);
            }
        }
        if (!tmask) break;
        __syncthreads();
        cur ^= 1;
    }
#undef NSA_LOAD
#undef NSA_PUT
}
__device__ __forceinline__ float wave_max64(float v) {
#pragma unroll
    for (int o = 1; o < 64; o <<= 1) v = fmaxf(v, __shfl_xor(v, o));
    return v;
}
__device__ __forceinline__ void nsa_unit(const Args& a, int l, int b, int qi, LAS unsigned char* lds, int tid, int lane, int wave) {
    LAS bf16_t* KVB = (LAS bf16_t*)lds;
    LAS float* IMP = (LAS float*)(lds + 37888);
    LAS unsigned long long* SELM = (LAS unsigned long long*)(lds + 104448);
    LAS float* INVL = (LAS float*)(lds + 105024);
    const bf16_t* QN = (const bf16_t*)(a.ws + WS_QN); const float* GATES = (const float*)(a.ws + WS_GATES); bf16_t* Y = (bf16_t*)(a.ws + WS_Y);
    const int fr = lane & 15, fq = lane >> 4, h = wave >> 1, qbase = (wave & 1) * 32;
    const size_t t0 = (size_t)b * SEQ + 64 * qi;
    const float slope2 = LOG2E * exp2f(-2.0f * (float)(h + 1));
    const float qmx = wave_max64(fabsf(INTAB(a)[20][l * 64 + lane]));
    const float bnd0 = 11.72f * qmx * wave_max64(fabsf(INTAB(a)[21][l * 192 + lane])), bnd1 = 11.72f * qmx * wave_max64(fabsf(INTAB(a)[21][l * 192 + 64 + lane])), bnd2 = 11.72f * qmx * wave_max64(fabsf(INTAB(a)[21][l * 192 + 128 + lane]));
    bf16x8 qf[2][2]; float gate[2][3];
#pragma unroll
    for (int mt = 0; mt < 2; ++mt) { const size_t t = t0 + qbase + 16 * mt + fr;
#pragma unroll
        for (int ks = 0; ks < 2; ++ks) qf[mt][ks] = *(const bf16x8*)(QN + t * 256 + h * 64 + 32 * ks + 8 * fq);
#pragma unroll
        for (int br = 0; br < 3; ++br) gate[mt][br] = GATES[t * 12 + h * 3 + br]; }
    for (int e = tid; e < 4 * 64 * 65; e += 512) IMP[e] = 0.f;
    f32x4 o[2][4]; LAS f32x4* OACC = (LAS f32x4*)IMP + tid; float lrow[2]; unsigned long long selm[2] = {0ull, 0ull};
    const f32x4 z4 = (f32x4){0.f, 0.f, 0.f, 0.f};
#pragma unroll
    for (int mt = 0; mt < 2; ++mt)
#pragma unroll
        for (int dt = 0; dt < 4; ++dt) o[mt][dt] = z4;
    const bf16_t* KC = (const bf16_t*)(a.ws + WS_KCMP) + (size_t)b * 256 * 64; const bf16_t* VC = (const bf16_t*)(a.ws + WS_VCMP) + (size_t)b * 256 * 64;
    const int ncmp = (4 * qi + 2) / 64 + 1; const unsigned long long cmask = (1ull << ncmp) - 1ull;
    lrow[0] = lrow[1] = 0.f;
    attn_tiles<1>(cmask, KC, VC, KVB, IMP + h * (64 * 65), qf, lrow, o, selm, qi, qbase, slope2, bnd0, tid, lane, wave);
#pragma unroll
    for (int mt = 0; mt < 2; ++mt) { float lt = lrow[mt]; lt += __shfl_xor(lt, 16); lt += __shfl_xor(lt, 32); const float il = lt > 0.f ? 1.0f / lt : 0.f;
        if (fq == 0) INVL[h * 64 + qbase + 16 * mt + fr] = il;
#pragma unroll
        for (int dt = 0; dt < 4; ++dt) o[mt][dt] = o[mt][dt] * (gate[mt][0] * il); }
    __syncthreads();
    {
        unsigned long long uni = 0ull;
        for (int qq = 0; qq < 8; ++qq) { const int q = wave * 8 + qq, j = lane;
            const float v = (IMP[q * 65 + j] * INVL[q] + IMP[4160 + q * 65 + j] * INVL[64 + q]) + (IMP[8320 + q * 65 + j] * INVL[128 + q] + IMP[12480 + q * 65 + j] * INVL[192 + q]);
            const bool forced = (j == 0) || (j == qi) || (j == qi - 1);
            const float val = (j <= qi) ? v + (forced ? 1e4f : 0.f) : -1.0f;
            const unsigned ub = __float_as_uint(val), key = (ub & 0x80000000u) ? ~ub : (ub | 0x80000000u);
            unsigned prefix = 0u;
#pragma unroll
            for (int bit = 31; bit >= 0; --bit) { const unsigned cand = prefix | (1u << bit); if (__builtin_popcountll(__ballot(key >= cand)) >= 16) prefix = cand; }
            const unsigned long long gtm = __ballot(key > prefix), eqm = __ballot(key == prefix);
            const int need = 16 - __builtin_popcountll(gtm);
            const bool pick = (key > prefix) || (key == prefix && __builtin_popcountll(eqm & ((1ull << lane) - 1ull)) < need);
            unsigned long long m = __ballot(pick);
            m &= (qi == 63) ? ~0ull : ((1ull << (qi + 1)) - 1ull);
            if (lane == 0) SELM[q] = m;
            uni |= m; }
        if (lane == 0) SELM[64 + wave] = uni;
    }
    __syncthreads();
    unsigned long long uni = 0ull;
#pragma unroll
    for (int w = 0; w < 8; ++w) uni |= SELM[64 + w];
    uni = ((unsigned long long)__builtin_amdgcn_readfirstlane((unsigned)(uni >> 32)) << 32) | (unsigned long long)__builtin_amdgcn_readfirstlane((unsigned)uni);
    selm[0] = SELM[qbase + fr]; selm[1] = SELM[qbase + 16 + fr];
#pragma unroll
    for (int mt = 0; mt < 2; ++mt)
#pragma unroll
        for (int dt = 0; dt < 4; ++dt) { OACC[(mt * 4 + dt) * 512] = o[mt][dt]; o[mt][dt] = z4; }
    lrow[0] = lrow[1] = 0.f;
    attn_tiles<2>(uni, (const bf16_t*)(a.ws + WS_KSEL) + (size_t)b * SEQ * 64, (const bf16_t*)(a.ws + WS_VSEL) + (size_t)b * SEQ * 64, KVB, IMP, qf, lrow, o, selm, qi, qbase, slope2, bnd1, tid, lane, wave);
#pragma unroll
    for (int mt = 0; mt < 2; ++mt) { float lt = lrow[mt]; lt += __shfl_xor(lt, 16); lt += __shfl_xor(lt, 32); const float sc = lt > 0.f ? gate[mt][1] / lt : 0.f;
#pragma unroll
        for (int dt = 0; dt < 4; ++dt) { OACC[(mt * 4 + dt) * 512] = OACC[(mt * 4 + dt) * 512] + o[mt][dt] * sc; o[mt][dt] = z4; } }
    const int jlo = qi >= 8 ? qi - 8 : 0;
    const unsigned long long wmask = ((qi == 63) ? ~0ull : ((1ull << (qi + 1)) - 1ull)) & ~((1ull << jlo) - 1ull);
    lrow[0] = lrow[1] = 0.f;
    attn_tiles<3>(wmask, (const bf16_t*)(a.ws + WS_KWIN) + (size_t)b * SEQ * 64, (const bf16_t*)(a.ws + WS_VWIN) + (size_t)b * SEQ * 64, KVB, IMP, qf, lrow, o, selm, qi, qbase, slope2, bnd2, tid, lane, wave);
#pragma unroll
    for (int mt = 0; mt < 2; ++mt) { float lt = lrow[mt]; lt += __shfl_xor(lt, 16); lt += __shfl_xor(lt, 32); const float sc = lt > 0.f ? gate[mt][2] / lt : 0.f;
        const size_t t = t0 + qbase + 16 * mt + fr;
#pragma unroll
        for (int dt = 0; dt < 4; ++dt) { const f32x4 r = OACC[(mt * 4 + dt) * 512] + o[mt][dt] * sc;
            u32x2 w; w.x = pk2(r[0], r[1]); w.y = pk2(r[2], r[3]);
            *(u32x2*)(Y + t * D + 512 + h * 64 + 16 * dt + 4 * fq) = w; } }
    __syncthreads();
}
__device__ __forceinline__ void nsa_phase(const Args& a, int l, int qslot, LAS unsigned char* lds, int tid, int lane, int wave) {
    unsigned* ctr = (unsigned*)(a.ws + WS_CTL) + 64 * qslot;
    LAS int* slot = (LAS int*)(lds + 106048);
    for (;;) {
        if (tid == 0) slot[0] = (int)atomicAdd(ctr, 1u);
        __syncthreads();
        const int u = slot[0];
        __syncthreads();
        if (u >= 512) break;
        const int b = u & 7, qi = 63 - (u >> 3);
        nsa_unit(a, l, b, qi, lds, tid, lane, wave);
    }
}
#ifndef PHM
#define PHM 0xffff
#endif
#ifndef DUP
#define DUP 0
#endif
#define REP(bit) if (rep_ == 0 || ((DUP >> (bit)) & 1))
__global__ void __launch_bounds__(512) mk_fwd(Args a) {
    extern __shared__ __attribute__((aligned(16))) unsigned char lds_raw[];
    LAS unsigned char* lds = (LAS unsigned char*)lds_raw;
#define OPQ() int tid = threadIdx.x; asm volatile("" : "+v"(tid)); const int lane = tid & 63, wave = __builtin_amdgcn_readfirstlane(tid >> 6); int bid = blockIdx.x; asm volatile("" : "+s"(bid)); int G = gridDim.x; asm volatile("" : "+s"(G));
    unsigned char* ws = a.ws;
    bf16_t* XB = (bf16_t*)(ws + WS_XB); bf16_t* H = (bf16_t*)(ws + WS_H); bf16_t* P = (bf16_t*)(ws + WS_P); bf16_t* Y = (bf16_t*)(ws + WS_Y); float* SSQ = (float*)(ws + WS_SSQ);
    volatile LAS unsigned* bst = (volatile LAS unsigned*)(lds + 147392);
    if (threadIdx.x < 2) bst[threadIdx.x] = 0u;
    __syncthreads();
#if MK_COOP
    XcdBarrier xbar = xcd_barrier_post((unsigned*)(a.ws + WS_BAR), bst);
    if (a.hi > 4096) cg::this_grid().sync();
#else
    XcdBarrier xbar; xbar.bar = (unsigned*)(a.ws + WS_BAR); xbar.x = 0; xbar.st = bst;
#endif
    for (int it = 2 * a.lo; it < 2 * a.hi; ++it) {
        const int ph = it >> 1, rep_ = it & 1;
        if (rep_) { const int s_ = ph == 0 ? -1 : (ph - 1) % 9; const int bits = ph == 0 ? 1 : (s_ == 0 || s_ == 7) ? 2 : s_ == 2 ? 8 : s_ == 3 ? 0x1f0 : s_ == 4 ? 0x600 : s_ == 5 ? 0x800 : 0; if (!(DUP & bits)) continue; }
        OPQ();
        if (ph == 0) { if (PHM & 1) REP(0) prologue(a, lds, tid, lane, wave, G, bid, rep_); }
        else {
            const int l = (ph - 1) / 9, s = (ph - 1) % 9;
            unsigned char* wb = ws + WS_W0 + (size_t)l * WS_LSTRIDE;
            if ((PHM & 2) && (s == 0 || s == 7)) { {
                pg8::Gemm g{XB, (const bf16_t*)(wb + (s == 0 ? WO_F1 : WO_F2)), T, NGU, D}; pg8::StaticOrder S; S.init(T, NGU, G, bid);
                pg8::EpiGU E{H, SSQ, FF};
                pg8::gemm_phase<pg8::EpiGU, pg8::StaticOrder, true, true>(lds, g, S, E); }
            } else if ((PHM & 4) && (s == 1 || s == 8)) {
                pg8::Gemm g{H, (const bf16_t*)(wb + (s == 1 ? WO_D1 : WO_D2)), T, D, FF}; pg8::StaticOrder S; S.init(T, D, G, bid);
                pg8::EpiRes E{(l == 0 && s == 1) ? a.in[0] : a.out, a.out, XB, SSQ, 0.5f};
                pg8::gemm_phase<pg8::EpiRes, pg8::StaticOrder, true, true>(lds, g, S, E);
            } else if ((PHM & 4) && s == 6) {
                pg8::Gemm g{Y, (const bf16_t*)(wb + WO_OUT), T, D, D}; pg8::StaticOrder S; S.init(T, D, G, bid);
                pg8::EpiRes E{a.out, a.out, XB, SSQ, 1.0f};
                pg8::gemm_phase<pg8::EpiRes, pg8::StaticOrder, true, true>(lds, g, S, E);
            } else if ((PHM & 8) && s == 2) { {
                pg8::Gemm g{XB, (const bf16_t*)(wb + WO_IN), T, PLD, D}; pg8::StaticOrder S; S.init(T, PLD, G, bid);
                pg8::EpiP E{P, SSQ, PLD};
                pg8::gemm_phase<pg8::EpiP, pg8::StaticOrder, true, true>(lds, g, S, E); }
            } else if (s == 3) {
                if (PHM & 16) REP(4) { OPQ(); pool_phase(a, l, lds, tid, lane, wave, G, bid); }
                if (PHM & 32) REP(5) { OPQ(); conv_phase(a, l, tid, G, bid); }
                if (PHM & 64) REP(6) { OPQ(); rwkv_prep_phase(a, l, lds, tid, lane, wave, G, bid); }
                if (PHM & 128) REP(7) { OPQ(); nsa_prep_phase(a, l, tid, G, bid); }
                if (PHM & 256) REP(8) { OPQ(); compress_phase(a, l, lds, tid, lane, wave, G, bid); }
            } else if (s == 4) {
                if (PHM & 512) REP(9) { OPQ(); scan_phase(a, lds, tid, lane, wave, G, bid); }
                if (PHM & 1024) REP(10) { OPQ(); nsa_phase(a, l, l * 2 + rep_, lds, tid, lane, wave); }
            } else if (s == 5) {
                if (PHM & 2048) REP(11) rwkv_out_phase(a, l, tid, G, bid);
            }
        }
        if (ph + 1 < a.hi) {
            xcd_barrier(xbar);
        }
    }
}

extern "C" void kernel_launch(void* const* d_in, const int* in_sizes, int n_in, void* d_out, int out_size, void* d_ws, size_t ws_size, hipStream_t stream) {
    static int grid = 0;
    if (grid == 0) {
        if (n_in != 33 || out_size != T * D || ws_size < WS_END) { fprintf(stderr, "kernel_launch: unexpected sizes n_in %d out %d ws %zu\n", n_in, out_size, ws_size); grid = -1; return; }
        int dev = 0, cus = 0, per_cu = 0;
        hipGetDevice(&dev); hipDeviceGetAttribute(&cus, hipDeviceAttributeMultiprocessorCount, dev);
        hipFuncSetAttribute((const void*)mk_fwd, hipFuncAttributeMaxDynamicSharedMemorySize, LDS_BYTES);
        if (hipOccupancyMaxActiveBlocksPerMultiprocessor(&per_cu, (const void*)mk_fwd, 512, LDS_BYTES) != hipSuccess || per_cu < 1) per_cu = 1;
        (void)hipGetLastError();
        grid = cus * per_cu;
    }
    if (grid < 0) return;
    Args a{};
    for (int i = 0; i < 33; ++i) a.in[i] = (const float*)d_in[i];
    a.out = (float*)d_out; a.ws = (unsigned char*)d_ws;
#if MK_COOP
    a.lo = 0; a.hi = NPH;
    if (hipMemsetAsync((char*)d_ws + WS_BAR, 0, XCD_BAR_WORDS * 4, stream) != hipSuccess) fprintf(stderr, "barrier memset failed\n");
    void* args[] = {&a};
    hipError_t e = hipLaunchCooperativeKernel((const void*)mk_fwd, dim3(grid), dim3(512), args, LDS_BYTES, stream);
    if (e != hipSuccess) fprintf(stderr, "cooperative launch failed: %s (grid %d)\n", hipGetErrorString(e), grid);
#else
    for (int ph = 0; ph < NPH; ++ph) { a.lo = ph; a.hi = ph + 1; hipLaunchKernelGGL(mk_fwd, dim3(grid), dim3(512), LDS_BYTES, stream, a); }
#endif
}
```

```cpp
#include <hip/hip_runtime.h>
#include <hip/hip_cooperative_groups.h>
#include <cstdio>
#include <cstdint>
namespace cg = cooperative_groups;
#ifndef MK_COOP
#define MK_COOP 1
#endif
namespace pg8 {
#define PG8_LAS __attribute__((address_space(3)))
typedef unsigned short bf16_t;
typedef short bf16x8 __attribute__((ext_vector_type(8)));
typedef float f32x4 __attribute__((ext_vector_type(4)));
typedef unsigned u32x4 __attribute__((ext_vector_type(4)));
constexpr int BM = 256, BK = 64, HALF = 128, HTB = HALF * BK * 2  , STAGE_BYTES = 8 * HTB, NXCD = 8, WGM = 8;

__host__ __device__ __forceinline__ int lds_byte(int r, int c) { const int st = (r >> 4) * 2 + (c >> 5), rr = r & 15, cc = c & 31, ob = rr * 64 + cc * 2; return st * 1024 + (ob ^ (((ob >> 9) & 1) << 5)); }
__host__ __device__ __forceinline__ void stage_rc(int b, int& R, int& C) { const int st = b / 1024, sb = b % 1024, swz = sb ^ (((sb >> 9) & 1) << 5); R = (st >> 1) * 16 + swz / 64; C = (st & 1) * 32 + (swz % 64) / 2; }
__host__ __device__ __forceinline__ int perm32(int rho) { const int n = rho >> 4, i = rho & 15; return 8 * (i >> 2) + 4 * n + (i & 3); }

struct Unit { int pm, pn; };
struct Gemm { const bf16_t* A; const bf16_t* Bt; int M, N, K; };

struct StaticOrder {
    int nM, nN, nwg, G, c;
    __host__ __device__ void init(int M, int N, int G_, int c_) { nM = M / BM; nN = N / BM; nwg = nM * nN; G = G_; c = c_; }
    __host__ __device__ bool next(int i, Unit& u) const {
        const long L = (long)i * G + c; if (L >= nwg) return false;
        int wgid = (int)L; { const int q = nwg / NXCD, r = nwg % NXCD, xcd = wgid % NXCD, off = wgid / NXCD; wgid = (xcd < r ? xcd * (q + 1) : r * (q + 1) + (xcd - r) * q) + off; }
        const int nig = WGM * nN, gid = wgid / nig, fm = gid * WGM, gsz = (nM - fm) < WGM ? (nM - fm) : WGM;
        u.pm = fm + ((wgid % nig) % gsz); u.pn = (wgid % nig) / gsz; return true;
    }
    __device__ __forceinline__ void a_ready(const Unit&) const {}
    __device__ __forceinline__ void done(const Unit&) const {}
};

__device__ __forceinline__ unsigned cvt_pk_bf16(float lo, float hi) { unsigned r; asm volatile("v_cvt_pk_bf16_f32 %0, %1, %2" : "=v"(r) : "v"(lo), "v"(hi)); return r; }
typedef float f32x2 __attribute__((ext_vector_type(2)));
__device__ __forceinline__ float row_rs(const float* ssq, int row, int fq) {
    const f32x4 s4 = *(const f32x4*)(ssq + (size_t)row * 16 + 4 * fq);
    float s = (s4[0] + s4[1]) + (s4[2] + s4[3]);
    s += __shfl_xor(s, 16); s += __shfl_xor(s, 32);
    return rsqrtf(s * (1.0f / 1024.0f) + 1e-6f);
}
__device__ __forceinline__ void row_rs8(const float* __restrict__ ssq, int row0, int fq, float (&rs)[2][4]) {
    f32x4 s4[2][4];
#pragma unroll
    for (int ai = 0; ai < 2; ++ai)
#pragma unroll
        for (int m = 0; m < 4; ++m) s4[ai][m] = *(const f32x4*)(ssq + (size_t)(row0 + ai * HALF + m * 16) * 16 + 4 * fq);
#pragma unroll
    for (int ai = 0; ai < 2; ++ai)
#pragma unroll
        for (int m = 0; m < 4; ++m) { float s = (s4[ai][m][0] + s4[ai][m][1]) + (s4[ai][m][2] + s4[ai][m][3]); s += __shfl_xor(s, 16); s += __shfl_xor(s, 32); rs[ai][m] = rsqrtf(s * (1.0f / 1024.0f) + 1e-6f); }
}
struct EpiGU {
    static constexpr bool PERM = true, AFTER_DRAIN = false;
    bf16_t* H; const float* ssq; int ldh;
    __device__ __forceinline__ void operator()(const f32x4 (&acc)[2][2][4][2], const Unit& u, int wr, int wc, int fr, int fq) const {
        float rs8[2][4]; row_rs8(ssq, u.pm * BM + wr * 64 + fr, fq, rs8);
#pragma unroll
        for (int ai = 0; ai < 2; ++ai)
#pragma unroll
            for (int m = 0; m < 4; ++m) {
                const int row = u.pm * BM + ai * HALF + wr * 64 + m * 16 + fr;
                const float rs = rs8[ai][m], rsl = -1.4426950408889634f * rs, rs2 = rs * rs;
                float hv[8];
#pragma unroll
                for (int n = 0; n < 2; ++n) {
                    const f32x4 ag = acc[ai][0][m][n], au = acc[ai][1][m][n];
                    const f32x4 ea = ag * rsl, gu = (ag * au) * rs2;
#pragma unroll
                    for (int j = 0; j < 4; ++j) hv[4 * n + j] = gu[j] * __builtin_amdgcn_rcpf(1.0f + __builtin_amdgcn_exp2f(ea[j]));
                }
                u32x4 w; w.x = cvt_pk_bf16(hv[0], hv[1]); w.y = cvt_pk_bf16(hv[2], hv[3]); w.z = cvt_pk_bf16(hv[4], hv[5]); w.w = cvt_pk_bf16(hv[6], hv[7]);
                *(u32x4*)(H + (size_t)row * ldh + u.pn * 128 + wc * 32 + 8 * fq) = w;
            }
    }
};
struct EpiRes {
    static constexpr bool PERM = true, AFTER_DRAIN = false;
    const float* Xin; float* X; bf16_t* XB; float* ssq; float alpha;
    __device__ __forceinline__ void operator()(const f32x4 (&acc)[2][2][4][2], const Unit& u, int wr, int wc, int fr, int fq) const {
        const size_t base = (size_t)(u.pm * BM + wr * 64 + fr) * 1024 + u.pn * BM + wc * 32 + 8 * fq;
#pragma unroll
        for (int ai = 0; ai < 2; ++ai) {
            f32x4 xv[4][2][2];
#pragma unroll
            for (int m = 0; m < 4; ++m)
#pragma unroll
                for (int bj = 0; bj < 2; ++bj)
#pragma unroll
                    for (int n = 0; n < 2; ++n) xv[m][bj][n] = *(const f32x4*)(Xin + base + (size_t)(ai * HALF + m * 16) * 1024 + bj * HALF + n * 4);
            asm volatile("" ::: "memory");
#pragma unroll
            for (int m = 0; m < 4; ++m) {
                float ss = 0.f;
#pragma unroll
                for (int bj = 0; bj < 2; ++bj) {
                    const size_t off = base + (size_t)(ai * HALF + m * 16) * 1024 + bj * HALF;
                    const f32x4 x0 = xv[m][bj][0] + acc[ai][bj][m][0] * alpha, x1 = xv[m][bj][1] + acc[ai][bj][m][1] * alpha;
                    *(f32x4*)(X + off) = x0; *(f32x4*)(X + off + 4) = x1;
                    u32x4 w; w.x = cvt_pk_bf16(x0[0], x0[1]); w.y = cvt_pk_bf16(x0[2], x0[3]); w.z = cvt_pk_bf16(x1[0], x1[1]); w.w = cvt_pk_bf16(x1[2], x1[3]);
                    *(u32x4*)(XB + off) = w;
                    ss += ((x0[0] * x0[0] + x0[1] * x0[1]) + (x0[2] * x0[2] + x0[3] * x0[3])) + ((x1[0] * x1[0] + x1[1] * x1[1]) + (x1[2] * x1[2] + x1[3] * x1[3]));
                }
                ss += __shfl_xor(ss, 16); ss += __shfl_xor(ss, 32);
                if (fq == 0) ssq[(size_t)(u.pm * BM + ai * HALF + wr * 64 + m * 16 + fr) * 16 + u.pn * 4 + wc] = ss;
            }
        }
    }
};
struct EpiP {
    static constexpr bool PERM = true, AFTER_DRAIN = false;
    bf16_t* P; const float* ssq; int ldp;
    __device__ __forceinline__ void operator()(const f32x4 (&acc)[2][2][4][2], const Unit& u, int wr, int wc, int fr, int fq) const {
        float rs8[2][4]; row_rs8(ssq, u.pm * BM + wr * 64 + fr, fq, rs8);
#pragma unroll
        for (int ai = 0; ai < 2; ++ai)
#pragma unroll
            for (int m = 0; m < 4; ++m) {
                const int row = u.pm * BM + ai * HALF + wr * 64 + m * 16 + fr;
                const float rs = rs8[ai][m];
#pragma unroll
                for (int bj = 0; bj < 2; ++bj) {
                    const f32x4 v0 = acc[ai][bj][m][0] * rs, v1 = acc[ai][bj][m][1] * rs;
                    u32x4 w; w.x = cvt_pk_bf16(v0[0], v0[1]); w.y = cvt_pk_bf16(v0[2], v0[3]); w.z = cvt_pk_bf16(v1[0], v1[1]); w.w = cvt_pk_bf16(v1[2], v1[3]);
                    *(u32x4*)(P + (size_t)row * ldp + u.pn * BM + bj * HALF + wc * 32 + 8 * fq) = w;
                }
            }
    }
};
template <class Epi, class Sched, bool ALIGN_EPI = false, bool SP2 = false>
__device__ __forceinline__ void gemm_phase(PG8_LAS unsigned char* lds, const Gemm g, const Sched& S, const Epi& E) {
    int tid = threadIdx.x; asm volatile("" : "+v"(tid));
    const int wid = __builtin_amdgcn_readfirstlane(tid >> 6), lane = tid & 63, wr = wid >> 2, wc = wid & 3, fr = lane & 15, fq = lane >> 4;
    const int K = g.K, nt = K / BK;
    unsigned voffA[2], voffB[2];
#pragma unroll
    for (int i = 0; i < 2; ++i) { int R, C; stage_rc(tid * 16 + i * 8192, R, C); const int Rb = Epi::PERM ? ((R & ~31) + perm32(R & 31)) : R;
        voffA[i] = (unsigned)(R * K + C) * 2u; voffB[i] = (unsigned)(Rb * K + C) * 2u; }
    const size_t kstep = (size_t)(BK * 2);
    const size_t hstep = (size_t)HALF * K * 2;
    const size_t tstep = 2 * hstep;
    const unsigned ldsw = (unsigned)wid * 1024u;
    const int aoff = lds_byte(wr * 64 + fr, fq * 8), boff = lds_byte(wc * 32 + fr, fq * 8);
#define PG8_SA(b, h) (((b) * 2 + (h)) * HTB)
#define PG8_SB(b, h) ((4 + (b) * 2 + (h)) * HTB)
#define PG8_STAGE(bufoff, gbase, voff) do { _Pragma("unroll") for (int _i = 0; _i < 2; ++_i) \
        __builtin_amdgcn_global_load_lds((const unsigned*)((const char*)(gbase) + (voff)[_i]), (PG8_LAS unsigned*)(lds + (bufoff) + ldsw + _i * 8192), 16, 0, 0); } while (0)
#define PG8_LDA(dst, b, h) do { _Pragma("unroll") for (int m = 0; m < 4; ++m) _Pragma("unroll") for (int k = 0; k < 2; ++k) dst[m][k] = *(const PG8_LAS bf16x8*)(lds + PG8_SA(b, h) + aoff + m * 2048 + k * 1024); } while (0)
#define PG8_LDB(dst, b, h) do { _Pragma("unroll") for (int n = 0; n < 2; ++n) _Pragma("unroll") for (int k = 0; k < 2; ++k) dst[n][k] = *(const PG8_LAS bf16x8*)(lds + PG8_SB(b, h) + boff + n * 2048 + k * 1024); } while (0)
#define PG8_MMA(ai, bj, At, Bt) do { __builtin_amdgcn_s_setprio(1); _Pragma("unroll") for (int m = 0; m < 4; ++m) _Pragma("unroll") for (int n = 0; n < 2; ++n) _Pragma("unroll") for (int k = 0; k < 2; ++k) \
        acc[ai][bj][m][n] = __builtin_amdgcn_mfma_f32_16x16x32_bf16(Bt[n][k], At[m][k], acc[ai][bj][m][n], 0, 0, 0); __builtin_amdgcn_s_setprio(0); } while (0)
#define PG8_WAIT_V(n) asm volatile("s_waitcnt vmcnt(" #n ")" ::: "memory")
#define PG8_WAIT_L(n) asm volatile("s_waitcnt lgkmcnt(" #n ")" ::: "memory")
#define PG8_BAR __builtin_amdgcn_s_barrier()
#define PG8_SCHED __builtin_amdgcn_sched_barrier(0)
    Unit cur, nxt; int ui = 0;
    if (!S.next(0, cur)) return;
    f32x4 acc[2][2][4][2];
#pragma unroll
    for (int a = 0; a < 2; ++a)
#pragma unroll
        for (int b = 0; b < 2; ++b)
#pragma unroll
            for (int m = 0; m < 4; ++m)
#pragma unroll
                for (int n = 0; n < 2; ++n) acc[a][b][m][n] = (f32x4){0.f, 0.f, 0.f, 0.f};
    bf16x8 At[4][2], B0[2][2], B1[2][2];
    const char* cA = (const char*)g.A + (size_t)cur.pm * tstep; const char* cB = (const char*)g.Bt + (size_t)cur.pn * tstep;
    S.a_ready(cur);
    if constexpr (SP2) {
        PG8_STAGE(PG8_SB(0, 0), cB, voffB); PG8_STAGE(PG8_SB(0, 1), cB + hstep, voffB); PG8_STAGE(PG8_SA(0, 0), cA, voffA); PG8_STAGE(PG8_SA(0, 1), cA + hstep, voffA);
        if (wr == 1) PG8_BAR;
        PG8_WAIT_V(2); PG8_BAR;
        PG8_STAGE(PG8_SB(1, 0), cB + kstep, voffB); PG8_STAGE(PG8_SA(1, 0), cA + kstep, voffA); PG8_STAGE(PG8_SB(1, 1), cB + hstep + kstep, voffB);
        PG8_WAIT_V(6); PG8_BAR;
    } else {
        PG8_STAGE(PG8_SB(0, 0), cB, voffB); PG8_STAGE(PG8_SA(0, 0), cA, voffA); PG8_STAGE(PG8_SB(0, 1), cB + hstep, voffB); PG8_STAGE(PG8_SA(0, 1), cA + hstep, voffA);
        if (wr == 1) PG8_BAR;
        PG8_WAIT_V(4); PG8_BAR;
        PG8_STAGE(PG8_SB(1, 0), cB + kstep, voffB); PG8_STAGE(PG8_SA(1, 0), cA + kstep, voffA); PG8_STAGE(PG8_SB(1, 1), cB + hstep + kstep, voffB);
        PG8_WAIT_V(6); PG8_BAR;
    }
    for (;;) {
        const bool has_next = S.next(ui + 1, nxt);
        const char* nA = has_next ? (const char*)g.A + (size_t)nxt.pm * tstep : cA; const char* nB = has_next ? (const char*)g.Bt + (size_t)nxt.pn * tstep : cB;
        for (int t = 0; t < nt; t += 2) {
            const bool last = (t == nt - 2);
            const char* a1 = cA + (size_t)(t + 1) * kstep;
            const char* a2 = last ? nA : cA + (size_t)(t + 2) * kstep; const char* b2 = last ? nB : cB + (size_t)(t + 2) * kstep;
            const char* a3 = a2 + kstep; const char* b3 = b2 + kstep;
            if (last && has_next) S.a_ready(nxt);
            if constexpr (SP2) {
            PG8_LDB(B0, 0, 0); PG8_LDB(B1, 0, 1); PG8_SCHED; PG8_LDA(At, 0, 0); PG8_STAGE(PG8_SA(1, 1), a1 + hstep, voffA);
            PG8_WAIT_V(8); PG8_WAIT_L(0); PG8_BAR; PG8_MMA(0, 0, At, B0); PG8_MMA(0, 1, At, B1); PG8_BAR; PG8_SCHED;
            PG8_LDA(At, 0, 1); PG8_STAGE(PG8_SB(0, 0), b2, voffB); PG8_STAGE(PG8_SB(0, 1), b2 + hstep, voffB); PG8_STAGE(PG8_SA(0, 0), a2, voffA);
            PG8_WAIT_V(8); PG8_WAIT_L(0); PG8_BAR; PG8_MMA(1, 0, At, B0); PG8_MMA(1, 1, At, B1); PG8_BAR; PG8_SCHED;
            PG8_LDB(B0, 1, 0); PG8_LDB(B1, 1, 1); PG8_SCHED; PG8_LDA(At, 1, 0); PG8_STAGE(PG8_SA(0, 1), a2 + hstep, voffA);
            PG8_WAIT_V(8); PG8_WAIT_L(0); PG8_BAR; PG8_MMA(0, 0, At, B0); PG8_MMA(0, 1, At, B1); PG8_BAR; PG8_SCHED;
            PG8_LDA(At, 1, 1); PG8_STAGE(PG8_SB(1, 0), b3, voffB); PG8_STAGE(PG8_SB(1, 1), b3 + hstep, voffB); PG8_STAGE(PG8_SA(1, 0), a3, voffA);
            PG8_WAIT_V(8); PG8_WAIT_L(0); PG8_BAR; PG8_MMA(1, 0, At, B0); PG8_MMA(1, 1, At, B1); PG8_BAR; PG8_SCHED;
            } else {
            PG8_LDB(B0, 0, 0); PG8_SCHED; PG8_LDA(At, 0, 0); PG8_STAGE(PG8_SA(1, 1), a1 + hstep, voffA);
            PG8_WAIT_L(8); PG8_BAR; PG8_WAIT_L(0); PG8_MMA(0, 0, At, B0); PG8_BAR; PG8_SCHED;
            PG8_LDB(B1, 0, 1); PG8_STAGE(PG8_SB(0, 0), b2, voffB);
            PG8_BAR; PG8_WAIT_L(0); PG8_MMA(0, 1, At, B1); PG8_BAR;
            PG8_LDA(At, 0, 1); PG8_STAGE(PG8_SA(0, 0), a2, voffA);
            PG8_BAR; PG8_WAIT_L(0); PG8_MMA(1, 0, At, B0); PG8_BAR; PG8_SCHED;
            PG8_STAGE(PG8_SB(0, 1), b2 + hstep, voffB);
            PG8_WAIT_V(6); PG8_BAR; PG8_MMA(1, 1, At, B1); PG8_BAR;
            PG8_LDB(B0, 1, 0); PG8_SCHED; PG8_LDA(At, 1, 0); PG8_STAGE(PG8_SA(0, 1), a2 + hstep, voffA);
            PG8_WAIT_L(8); PG8_BAR; PG8_WAIT_L(0); PG8_MMA(0, 0, At, B0); PG8_BAR; PG8_SCHED;
            PG8_LDB(B1, 1, 1); PG8_STAGE(PG8_SB(1, 0), b3, voffB);
            PG8_BAR; PG8_WAIT_L(0); PG8_MMA(0, 1, At, B1); PG8_BAR;
            PG8_LDA(At, 1, 1); PG8_STAGE(PG8_SA(1, 0), a3, voffA);
            PG8_BAR; PG8_WAIT_L(0); PG8_MMA(1, 0, At, B0); PG8_BAR; PG8_SCHED;
            PG8_STAGE(PG8_SB(1, 1), b3 + hstep, voffB);
            PG8_WAIT_V(6); PG8_BAR; PG8_MMA(1, 1, At, B1); PG8_BAR;
            }
        }
        if constexpr (ALIGN_EPI) { if (wr == 0) PG8_BAR; }
        if constexpr (!Epi::AFTER_DRAIN) { E(acc, cur, wr, wc, fr, fq); S.done(cur); }
        if (!has_next) break;
#pragma unroll
        for (int a = 0; a < 2; ++a)
#pragma unroll
            for (int b = 0; b < 2; ++b)
#pragma unroll
                for (int m = 0; m < 4; ++m)
#pragma unroll
                    for (int n = 0; n < 2; ++n) acc[a][b][m][n] = (f32x4){0.f, 0.f, 0.f, 0.f};
        cur = nxt; cA = nA; cB = nB; ++ui;
        if constexpr (ALIGN_EPI) { if (wr == 1) PG8_BAR; }
    }
    PG8_WAIT_V(0);
    if constexpr (!ALIGN_EPI) { if (wr == 0) PG8_BAR; }
    PG8_BAR;
    if constexpr (Epi::AFTER_DRAIN) { E.fused(acc, cur, wr, wc, fr, fq, lds, wid, lane); S.done(cur); }
#undef PG8_SA
#undef PG8_SB
#undef PG8_STAGE
#undef PG8_LDA
#undef PG8_LDB
#undef PG8_MMA
#undef PG8_WAIT_V
#undef PG8_WAIT_L
#undef PG8_BAR
#undef PG8_SCHED
}
}
using pg8::bf16_t; using pg8::bf16x8; using pg8::f32x4; using pg8::u32x4;
typedef unsigned u32x2 __attribute__((ext_vector_type(2)));
#define LAS __attribute__((address_space(3)))
constexpr int NB = 8, SEQ = 4096, T = NB * SEQ, D = 1024, FF = 2816, PT = 2604, PLD = 2816, NGU = 2 * FF;
constexpr int PC_A = 0, PC_B = 256, PC_Q = 1184, PC_KC = 1440, PC_VC = 1504, PC_KS = 1568, PC_VS = 1632, PC_KW = 1696, PC_VW = 1760, PC_U = 1824, PC_BB = 2080, PC_CC = 2336, PC_G = 2592;
constexpr size_t MiB = 1u << 20;
constexpr size_t WS_CTL = 0;
constexpr size_t WS_W0 = 1 * MiB, WS_LSTRIDE = 42 * MiB;
constexpr size_t WO_F1 = 0, WO_D1 = 11 * MiB, WO_F2 = 33 * MiB / 2, WO_D2 = 55 * MiB / 2, WO_IN = 33 * MiB, WO_OUT = 77 * MiB / 2, WO_CK = 81 * MiB / 2, WO_CV = 41 * MiB;
constexpr size_t WS_CBP = 85 * MiB;
constexpr size_t WS_SSQ = 86 * MiB;
constexpr size_t WS_P = 96 * MiB, WS_H = 96 * MiB, WS_YR = 96 * MiB;
constexpr size_t WS_XB = 272 * MiB;
constexpr size_t WS_R = 272 * MiB, WS_K = 288 * MiB, WS_V = 304 * MiB, WS_KK = 320 * MiB, WS_AKK = 336 * MiB, WS_GG = 352 * MiB, WS_DEC = 368 * MiB;
constexpr size_t WS_QN = 400 * MiB, WS_KSEL = 416 * MiB, WS_VSEL = 420 * MiB, WS_KWIN = 424 * MiB, WS_VWIN = 428 * MiB, WS_GATES = 432 * MiB, WS_KCMP = 434 * MiB, WS_VCMP = 434 * MiB + 512 * 1024;
constexpr size_t WS_Y = 440 * MiB, WS_END = 504 * MiB;
constexpr int LDS_BYTES = 147456;
constexpr int NPH = 19;

struct Args { const float* in[33]; float* out; unsigned char* ws; int lo, hi; };
constexpr size_t WS_IMG = 131072, IMG_LSTRIDE = 176128, IMG_RW = 0, IMG_POOL = 94208, IMG_W2 = 131072;
constexpr size_t WS_TAB = 65536;
#define INTAB(a) ((const float* const*)((a).ws + WS_TAB))

__device__ __forceinline__ float bf_lo(unsigned u) { return __uint_as_float(u << 16); }
__device__ __forceinline__ float bf_hi(unsigned u) { return __uint_as_float(u & 0xffff0000u); }
__device__ __forceinline__ float bf2f(bf16_t h) { return __uint_as_float((unsigned)h << 16); }
__device__ __forceinline__ unsigned f2bf(float f) { unsigned u = __float_as_uint(f); return (u + 0x7fffu + ((u >> 16) & 1u)) >> 16; }
__device__ __forceinline__ unsigned pk2(float lo, float hi) { return pg8::cvt_pk_bf16(lo, hi); }
__device__ __forceinline__ float sigmoidf_(float x) { return __builtin_amdgcn_rcpf(1.0f + __expf(-x)); }
#define LDS_WAIT() asm volatile("s_waitcnt lgkmcnt(0)" ::: "memory")
__device__ __forceinline__ f32x4 mma16(const LAS bf16_t* A, int lda, const LAS bf16_t* Bt, int ldb, int K, int lane, f32x4 acc) {
    const LAS bf16_t* ap = A + (lane & 15) * lda + (lane >> 4) * 8;
    const LAS bf16_t* bp = Bt + (lane & 15) * ldb + (lane >> 4) * 8;
    for (int k0 = 0; k0 < K; k0 += 32) {
        const bf16x8 av = *(const LAS bf16x8*)(ap + k0), bv = *(const LAS bf16x8*)(bp + k0);
        acc = __builtin_amdgcn_mfma_f32_16x16x32_bf16(bv, av, acc, 0, 0, 0);
    }
    return acc;
}
__device__ __forceinline__ float red8(float v) { v += __shfl_xor(v, 1); v += __shfl_xor(v, 2); v += __shfl_xor(v, 4); return v; }
__device__ __forceinline__ float red16(float v) { v += __shfl_xor(v, 1); v += __shfl_xor(v, 2); v += __shfl_xor(v, 4); v += __shfl_xor(v, 8); return v; }
template <int CTRL> __device__ __forceinline__ float dpp_add(float x) {
    return x + __builtin_bit_cast(float, __builtin_amdgcn_update_dpp(0, __builtin_bit_cast(int, x), CTRL, 0xf, 0xf, true));
}
template <int CTRL> __device__ __forceinline__ float dpp_get(float x) { return __builtin_bit_cast(float, __builtin_amdgcn_update_dpp(0, __builtin_bit_cast(int, x), CTRL, 0xf, 0xf, true)); }
__device__ __forceinline__ float allred16_dpp(float x) { x = dpp_add<0x128>(x); x = dpp_add<0x124>(x); x = dpp_add<0x122>(x); x = dpp_add<0x121>(x); return x; }

constexpr size_t WS_BAR = 32768;
#define XB_TMO      128
#define XB_XCNT(j)  (256  + 64 * (j))
#define XB_XSUB(j)  (1280 + 64 * (j))
#define XB_XGEN(j)  (2304 + 64 * (j))
#define XB_TOP      3328
#define XB_TOPGEN   3392
#define XCD_BAR_WORDS 3456
#define XB_SPIN_CAP (1u << 18)

__device__ __forceinline__ unsigned xb_ld(unsigned* p)              { return __hip_atomic_load(p, __ATOMIC_RELAXED, __HIP_MEMORY_SCOPE_AGENT); }
__device__ __forceinline__ unsigned xb_add(unsigned* p, unsigned v) { return __hip_atomic_fetch_add(p, v, __ATOMIC_RELAXED, __HIP_MEMORY_SCOPE_AGENT); }
__device__ __forceinline__ unsigned xb_xcc_id() { return (unsigned)__builtin_amdgcn_s_getreg((3 << 11) | 20) & 0xFu; }
#define XB_SPIN(cond, bar) do { unsigned _sp = 0; while (cond) { __builtin_amdgcn_s_sleep(1); \
    if ((++_sp & 255u) == 0u) { if (xb_ld(&(bar)[XB_TMO])) break; if (_sp > XB_SPIN_CAP) { atomicAdd(&(bar)[XB_TMO], 1u); break; } } } } while (0)

struct XcdBarrier {
    unsigned* bar; unsigned x;
    volatile LAS unsigned* st;
};

__device__ __forceinline__ XcdBarrier xcd_barrier_post(unsigned* bar, volatile LAS unsigned* st) {
    XcdBarrier b; b.bar = bar; b.x = xb_xcc_id(); b.st = st;
    if (threadIdx.x == 0) (void)xb_add(&bar[XB_XCNT(b.x)], 1u);
    return b;
}
__device__ __forceinline__ void xcd_barrier_complete(unsigned* bar, unsigned x, unsigned& nloc, unsigned& nx) {
    const unsigned G = gridDim.x * gridDim.y * gridDim.z;
    unsigned sum, cnt, mine, sp = 0u;
    for (;;) {
        sum = 0u; cnt = 0u; mine = 0u;
#pragma unroll
        for (unsigned j = 0; j < 16; ++j) { const unsigned c = xb_ld(&bar[XB_XCNT(j)]); sum += c; cnt += (c > 0u) ? 1u : 0u; mine = (j == x) ? c : mine; }
        if (sum == G) break;
        __builtin_amdgcn_s_sleep(1);
        if ((++sp & 255u) == 0u) { if (xb_ld(&bar[XB_TMO])) break; if (sp > XB_SPIN_CAP) { atomicAdd(&bar[XB_TMO], 1u); break; } }
    }
    nloc = mine > 0u ? mine : 1u; nx = cnt > 0u ? cnt : 1u;
}

__device__ __forceinline__ void xcd_barrier(const XcdBarrier& b) {
    asm volatile("s_waitcnt vmcnt(0)" ::: "memory");
    __syncthreads();
    if (threadIdx.x == 0) {
        unsigned* bar = b.bar;
        __builtin_amdgcn_s_waitcnt(0);
        unsigned nloc = b.st[0], nx = b.st[1];
        if (nloc == 0u) { xcd_barrier_complete(bar, b.x, nloc, nx); b.st[0] = nloc; b.st[1] = nx; }
        const unsigned old = xb_add(&bar[XB_XSUB(b.x)], 1u);
        const unsigned gen = old / nloc;
        if (old + 1u == (gen + 1u) * nloc) {
            __builtin_amdgcn_fence(__ATOMIC_RELEASE, "agent");
            asm volatile("s_waitcnt vmcnt(0)" ::: "memory");
            const unsigned og = xb_add(&bar[XB_TOP], 1u);
            const unsigned tg = og / nx;
            if (og + 1u == (tg + 1u) * nx) xb_add(&bar[XB_TOPGEN], 1u);
            else XB_SPIN(xb_ld(&bar[XB_TOPGEN]) == tg, bar);
            __builtin_amdgcn_fence(__ATOMIC_ACQUIRE, "agent");
            xb_add(&bar[XB_XGEN(b.x)], 1u);
            asm volatile("s_waitcnt vmcnt(0)" ::: "memory");
        } else {
            XB_SPIN(xb_ld(&bar[XB_XGEN(b.x)]) == gen, bar);
            __builtin_amdgcn_fence(__ATOMIC_ACQUIRE, "agent");
            asm volatile("s_waitcnt vmcnt(0)" ::: "memory");
        }
    }
    __syncthreads();
}

__device__ __forceinline__ int rowmap(int kind, int n) {
    if (kind == 0) return 256 * (n >> 7) + (n & 127);
    if (kind == 1) return 256 * (n >> 7) + 128 + (n & 127);
    if (kind == 3) return n < 1824 ? n : (n < 1836 ? PC_G + (n - 1824) : n - 12);
    return n;
}
struct TrDesc { const float* W; const float* gain; bf16_t* WT; int K, N, kind, k0, n0; };
__device__ __forceinline__ void tr_desc(const Args& a, int it, TrDesc& d) {
    constexpr int I_GU = 16 * 88, I_DN = 44 * 32, I_IN = 16 * 82, I_OUT = 16 * 32, I_C = 32 * 4;
    constexpr int I_LAYER = 4 * I_GU + 2 * I_DN + I_IN + I_OUT + 2 * I_C;
    const int l = it / I_LAYER; int r = it - l * I_LAYER;
    unsigned char* wb = a.ws + WS_W0 + (size_t)l * WS_LSTRIDE;
    const float* W; const float* gain = nullptr; bf16_t* WT; int K, N, kind;
    if (r < I_GU) { W = a.in[2] + (size_t)l * D * FF; K = D; N = FF; WT = (bf16_t*)(wb + WO_F1); kind = 0; gain = a.in[1] + l * D; }
    else if ((r -= I_GU) < I_GU) { W = a.in[3] + (size_t)l * D * FF; K = D; N = FF; WT = (bf16_t*)(wb + WO_F1); kind = 1; gain = a.in[1] + l * D; }
    else if ((r -= I_GU) < I_DN) { W = a.in[4] + (size_t)l * D * FF; K = FF; N = D; WT = (bf16_t*)(wb + WO_D1); kind = 2; }
    else if ((r -= I_DN) < I_GU) { W = a.in[30] + (size_t)l * D * FF; K = D; N = FF; WT = (bf16_t*)(wb + WO_F2); kind = 0; gain = a.in[29] + l * D; }
    else if ((r -= I_GU) < I_GU) { W = a.in[31] + (size_t)l * D * FF; K = D; N = FF; WT = (bf16_t*)(wb + WO_F2); kind = 1; gain = a.in[29] + l * D; }
    else if ((r -= I_GU) < I_DN) { W = a.in[32] + (size_t)l * D * FF; K = FF; N = D; WT = (bf16_t*)(wb + WO_D2); kind = 2; }
    else if ((r -= I_DN) < I_IN) { W = a.in[6] + (size_t)l * D * PT; K = D; N = PT; WT = (bf16_t*)(wb + WO_IN); kind = 3; gain = a.in[5] + l * D; }
    else if ((r -= I_IN) < I_OUT) { W = a.in[28] + (size_t)l * D * D; K = D; N = D; WT = (bf16_t*)(wb + WO_OUT); kind = 2; }
    else if ((r -= I_OUT) < I_C) { W = a.in[23] + (size_t)l * 2048 * 128; K = 2048; N = 128; WT = (bf16_t*)(wb + WO_CK); kind = 2; }
    else { r -= I_C; W = a.in[25] + (size_t)l * 2048 * 128; K = 2048; N = 128; WT = (bf16_t*)(wb + WO_CV); kind = 2; }
    const int nblk = (N + 31) >> 5, kb = r / nblk, nb = r - kb * nblk;
    d.W = W; d.gain = gain; d.WT = WT; d.K = K; d.N = N; d.kind = kind; d.k0 = 64 * kb; d.n0 = 32 * nb;
}
__device__ __forceinline__ void tr_load(const TrDesc& d, int lane, f32x4 (&v)[8]) {
    const int q4 = lane & 7, kr = lane >> 3, nn = d.n0 + 4 * q4, nc = nn < d.N ? nn : d.N - 4;
#pragma unroll
    for (int i = 0; i < 8; ++i) { const int kk = d.k0 + 8 * i + kr; f32x4 x = __builtin_nontemporal_load((const f32x4*)(d.W + (size_t)kk * d.N + nc));
        if (d.gain) x = x * d.gain[kk];
        if (nn >= d.N) x = (f32x4){0.f, 0.f, 0.f, 0.f};
        v[i] = x; }
}
__device__ __forceinline__ void tr_store(const TrDesc& d, int lane, const f32x4 (&v)[8], LAS float* scr) {
    { const int q4 = lane & 7, kr = lane >> 3;
#pragma unroll
      for (int i = 0; i < 8; ++i) { LAS float* p = scr + (8 * i + kr) * 33 + 4 * q4; p[0] = v[i][0]; p[1] = v[i][1]; p[2] = v[i][2]; p[3] = v[i][3]; } }
    LDS_WAIT();
    const int c = lane & 7;
#pragma unroll
    for (int j = 0; j < 4; ++j) { const int nl = (lane >> 3) + 8 * j, n = d.n0 + nl; const LAS float* s = scr + (8 * c) * 33 + nl;
        u32x4 o; o.x = pk2(s[0 * 33], s[1 * 33]); o.y = pk2(s[2 * 33], s[3 * 33]); o.z = pk2(s[4 * 33], s[5 * 33]); o.w = pk2(s[6 * 33], s[7 * 33]);
        if (n < d.N) *(u32x4*)(d.WT + (size_t)rowmap(d.kind, n) * d.K + d.k0 + 8 * c) = o; }
    LDS_WAIT();
}
__device__ __forceinline__ void prologue(const Args& a, LAS unsigned char* lds, int tid, int lane, int wave, int G, int bid, int rep) {
    LAS float* scr = (LAS float*)(lds + wave * 16384);
    const int gw = bid * 8 + wave, NGW = G * 8;
    if (bid == 0 && rep == 0 && tid < 64) ((unsigned*)(a.ws + WS_CTL))[tid * 64] = 0u;
    if (bid == 0 && tid < 33) ((const float**)(a.ws + WS_TAB))[tid] = a.in[tid];
    {
        constexpr int I_TOTAL = 2 * (4 * 16 * 88 + 2 * 44 * 32 + 16 * 82 + 16 * 32 + 2 * 32 * 4);
        TrDesc dc{}, dn{}; f32x4 vc[8] = {}, vn[8] = {};
        int it = gw;
        if (it < I_TOTAL) { tr_desc(a, it, dc); tr_load(dc, lane, vc); }
        while (it < I_TOTAL) {
            const int itn = it + NGW;
            if (itn < I_TOTAL) { tr_desc(a, itn, dn); tr_load(dn, lane, vn); }
            tr_store(dc, lane, vc, scr);
            dc = dn;
#pragma unroll
            for (int i = 0; i < 8; ++i) vc[i] = vn[i];
            it = itn;
        }
    }
    {
        const float* x = a.in[0]; bf16_t* XB = (bf16_t*)(a.ws + WS_XB); float* ssq = (float*)(a.ws + WS_SSQ);
#pragma unroll 4
        for (int m = gw; m < T; m += NGW) {
            const f32x4* xr = (const f32x4*)(x + (size_t)m * D) + lane; u32x2* brow = (u32x2*)(XB + (size_t)m * D) + lane;
#pragma unroll
            for (int j = 0; j < 4; ++j) { const f32x4 v = __builtin_nontemporal_load(xr + 64 * j); u32x2 w; w.x = pk2(v[0], v[1]); w.y = pk2(v[2], v[3]); brow[64 * j] = w;
                float ss = (v[0] * v[0] + v[1] * v[1]) + (v[2] * v[2] + v[3] * v[3]); ss = red16(ss);
                if ((lane & 15) == 0) ssq[(size_t)m * 16 + 4 * j + (lane >> 4)] = ss; }
        }
    }
    for (int e = bid * 512 + tid; e < 2 * 73728; e += G * 512) {
        const int l = e / 73728; int r = e - l * 73728; bf16_t* img = (bf16_t*)(a.ws + WS_IMG + (size_t)l * IMG_LSTRIDE);
        if (r < 16384) { const int k = r >> 8, n = r & 255, np = ((n & ~63) + 16 * (2 * ((n & 63) >> 5) + ((n >> 2) & 1)) + 4 * ((n >> 3) & 3) + (n & 3)); img[IMG_RW / 2 + np * 72 + k] = (bf16_t)f2bf(a.in[11][l * 16384 + r]); continue; } r -= 16384;
        if (r < 8192) { const int k = r >> 8, n = r & 255, np = ((n & ~63) + 16 * (2 * ((n & 63) >> 5) + ((n >> 2) & 1)) + 4 * ((n >> 3) & 3) + (n & 3)); img[IMG_RW / 2 + 18432 + np * 40 + k] = (bf16_t)f2bf(a.in[13][l * 8192 + r]); continue; } r -= 8192;
        if (r < 16384) { const int k = r >> 8, n = r & 255, np = ((n & ~63) + 16 * (2 * ((n & 63) >> 5) + ((n >> 2) & 1)) + 4 * ((n >> 3) & 3) + (n & 3)); img[IMG_RW / 2 + 28672 + np * 72 + k] = (bf16_t)f2bf(a.in[14][l * 16384 + r]); continue; } r -= 16384;
        if (r < 16384) { const int g = r >> 12, c = (r >> 6) & 63, d = r & 63; img[IMG_POOL / 2 + (g * 64 + d) * 72 + c] = (bf16_t)f2bf(a.in[7][l * 16384 + r]); continue; } r -= 16384;
        { const int kv = r >> 13, j = (r >> 6) & 127, d = r & 63; img[IMG_W2 / 2 + (kv * 64 + d) * 136 + j] = (bf16_t)f2bf((kv ? a.in[26] : a.in[24])[l * 8192 + (r & 8191)]); }
    }
    __syncthreads();
    for (int task = bid; task < 256; task += G) {
        const int l = task >> 7, kv = (task >> 6) & 1, part = task & 63;
        const float* pos = a.in[22] + l * 2048; const float* w1 = (kv ? a.in[25] : a.in[23]) + (size_t)l * 2048 * 128;
        const int j = tid & 127, sub = tid >> 7; float s = 0.f;
#pragma unroll
        for (int i = 0; i < 8; ++i) { const int ii = part * 32 + sub * 8 + i; s += pos[ii] * w1[(size_t)ii * 128 + j]; }
        LAS float* red = (LAS float*)lds;
        __syncthreads(); red[tid] = s; __syncthreads();
        if (tid < 128) ((float*)(a.ws + WS_CBP))[((l * 2 + kv) * 64 + part) * 128 + tid] = (red[tid] + red[tid + 128]) + (red[tid + 256] + red[tid + 384]);
    }
    __syncthreads();
}
__device__ __forceinline__ void pool_phase(const Args& a, int l, LAS unsigned char* lds, int tid, int lane, int wave, int G, int bid) {
    const bf16_t* P = (const bf16_t*)(a.ws + WS_P); bf16_t* Y = (bf16_t*)(a.ws + WS_Y);
    LAS bf16_t* U = (LAS bf16_t*)lds;
    LAS bf16_t* Dm = (LAS bf16_t*)(lds + 40960);
    LAS bf16_t* Wt = (LAS bf16_t*)(lds + 40960 + 33792);
    const float* pw = INTAB(a)[7] + l * 16384; const float* psc = INTAB(a)[8] + l * 256;
    { const u32x4* img = (const u32x4*)(a.ws + WS_IMG + (size_t)l * IMG_LSTRIDE + IMG_POOL); u32x4 r[5];
#pragma unroll
      for (int i = 0; i < 5; ++i) { const int q = tid + 512 * i; r[i] = img[q < 2304 ? q : 2303]; }
#pragma unroll
      for (int i = 0; i < 5; ++i) { const int q = tid + 512 * i; if (q < 2304) *(LAS u32x4*)((LAS unsigned char*)Wt + q * 16) = r[i]; } }
    for (int tile = bid; tile < T / 64; tile += G) {
        const int t0 = tile * 64, s0 = t0 & (SEQ - 1);
        __syncthreads();
        { u32x4 rr[5];
#pragma unroll
          for (int i = 0; i < 5; ++i) { const int pc = tid + 512 * i, r = pc >> 5, c8 = pc & 31, s = s0 - 16 + r; const int rowc = s >= 0 ? t0 - 16 + r : t0;
              rr[i] = *(const u32x4*)(P + (size_t)rowc * PLD + PC_A + c8 * 8); if (s < 0) rr[i] = (u32x4){0u, 0u, 0u, 0u}; }
#pragma unroll
          for (int i = 0; i < 5; ++i) { const int pc = tid + 512 * i, r = pc >> 5, c8 = pc & 31; *(LAS u32x4*)(U + r * 256 + c8 * 8) = rr[i]; } }
        __syncthreads();
        { const int c = tid & 255, half = tid >> 8, wlen = 2 << (c >> 6), tk0 = half * 32;
          float sum = 0.f;
          for (int jj = 1; jj < wlen; ++jj) sum += bf2f(U[(tk0 + 16 - jj) * 256 + c]);
#pragma unroll 8
          for (int tk = tk0; tk < tk0 + 32; ++tk) { const int r = tk + 16, s = s0 + tk, cnt = (s + 1 < wlen) ? s + 1 : wlen;
              const float cur = bf2f(U[r * 256 + c]), old = bf2f(U[(r - wlen + 1) * 256 + c]); sum += cur;
              Dm[tk * 264 + c] = (bf16_t)f2bf(sum * __builtin_amdgcn_rcpf((float)cnt) - cur); sum -= old; } }
        __syncthreads();
#pragma unroll
        for (int x = 0; x < 2; ++x) { const int nt = 2 * wave + x, g = nt >> 2;
            for (int mt = 0; mt < 4; ++mt) {
                f32x4 acc = mma16(Dm + 16 * mt * 264 + g * 64, 264, Wt + (g * 64 + (nt & 3) * 16) * 72, 72, 64, lane, (f32x4){0.f, 0.f, 0.f, 0.f});
                const int tok = 16 * mt + (lane & 15), col = 16 * nt + 4 * (lane >> 4); const f32x4 sc = *(const f32x4*)(psc + col);
                u32x2 w; w.x = pk2(acc[0] * sc[0], acc[1] * sc[1]); w.y = pk2(acc[2] * sc[2], acc[3] * sc[3]);
                *(u32x2*)(Y + (size_t)(t0 + tok) * D + col) = w; } }
    }
    __syncthreads();
}
__device__ __forceinline__ void unpack8(const u32x4 v, float (&f)[8]) {
    f[0] = bf_lo(v.x); f[1] = bf_hi(v.x); f[2] = bf_lo(v.y); f[3] = bf_hi(v.y); f[4] = bf_lo(v.z); f[5] = bf_hi(v.z); f[6] = bf_lo(v.w); f[7] = bf_hi(v.w);
}
__device__ __forceinline__ void conv_phase(const Args& a, int l, int tid, int G, int bid) {
    const bf16_t* __restrict__ P = (const bf16_t*)(a.ws + WS_P); bf16_t* __restrict__ Y = (bf16_t*)(a.ws + WS_Y);
    const float* __restrict__ cw = INTAB(a)[27] + l * 768;
    const int ch = (tid & 31) * 8;
    float w0[8], w1[8], w2[8];
#pragma unroll
    for (int e = 0; e < 8; ++e) { w0[e] = cw[ch + e]; w1[e] = cw[256 + ch + e]; w2[e] = cw[512 + ch + e]; }
#pragma unroll 4
    for (int t = bid * 16 + (tid >> 5); t < T; t += G * 16) {
        const int s = t & (SEQ - 1);
        const bf16_t* pr = P + (size_t)t * PLD;
        const u32x4 z4 = (u32x4){0u, 0u, 0u, 0u};
        const u32x4 u0 = *(const u32x4*)(pr + PC_U + ch), c0 = *(const u32x4*)(pr + PC_CC + ch), b0 = *(const u32x4*)(pr + PC_BB + ch);
        const bf16_t* pr1 = s >= 1 ? pr - PLD : pr; const bf16_t* pr2 = s >= 2 ? pr - 2 * PLD : pr;
        u32x4 u1 = *(const u32x4*)(pr1 + PC_U + ch), c1 = *(const u32x4*)(pr1 + PC_CC + ch), u2 = *(const u32x4*)(pr2 + PC_U + ch), c2 = *(const u32x4*)(pr2 + PC_CC + ch);
        if (s < 1) { u1 = z4; c1 = z4; } if (s < 2) { u2 = z4; c2 = z4; }
        float fu0[8], fc0[8], fb0[8], fu1[8], fc1[8], fu2[8], fc2[8], o[8];
        unpack8(u0, fu0); unpack8(c0, fc0); unpack8(b0, fb0); unpack8(u1, fu1); unpack8(c1, fc1); unpack8(u2, fu2); unpack8(c2, fc2);
#pragma unroll
        for (int e = 0; e < 8; ++e) o[e] = fb0[e] * (w0[e] * (fc2[e] * fu2[e]) + w1[e] * (fc1[e] * fu1[e]) + w2[e] * (fc0[e] * fu0[e]));
        u32x4 w; w.x = pk2(o[0], o[1]); w.y = pk2(o[2], o[3]); w.z = pk2(o[4], o[5]); w.w = pk2(o[6], o[7]);
        *(u32x4*)(Y + (size_t)t * D + 768 + ch) = w;
    }
}
__device__ __forceinline__ void rwkv_prep_phase(const Args& a, int l, LAS unsigned char* lds, int tid, int lane, int wave, int G, int bid) {
    const bf16_t* __restrict__ P = (const bf16_t*)(a.ws + WS_P);
    LAS bf16_t* WU = (LAS bf16_t*)lds;
    LAS bf16_t* AU = (LAS bf16_t*)(lds + 36864);
    LAS bf16_t* GU = (LAS bf16_t*)(lds + 57344);
    LAS bf16_t* Tw = (LAS bf16_t*)(lds + 94208);
    LAS bf16_t* Ta = (LAS bf16_t*)(lds + 103424);
    LAS bf16_t* Tg = (LAS bf16_t*)(lds + 108544);
    LAS float* WT7 = (LAS float*)(lds + 117760);
    const float* mu = INTAB(a)[9] + l * 928; const float* w0 = INTAB(a)[10] + l * 256; const float* wup = INTAB(a)[11] + l * 64 * 256; const float* a0 = INTAB(a)[12] + l * 256;
    const float* aup = INTAB(a)[13] + l * 32 * 256; const float* gup = INTAB(a)[14] + l * 64 * 256; const float* kkw = INTAB(a)[15] + l * 256; const float* kaw = INTAB(a)[16] + l * 256;
    bf16_t* __restrict__ Ro = (bf16_t*)(a.ws + WS_R); bf16_t* __restrict__ Ko = (bf16_t*)(a.ws + WS_K); bf16_t* __restrict__ Vo = (bf16_t*)(a.ws + WS_V); bf16_t* __restrict__ KKo = (bf16_t*)(a.ws + WS_KK);
    bf16_t* __restrict__ AKKo = (bf16_t*)(a.ws + WS_AKK); bf16_t* __restrict__ Go = (bf16_t*)(a.ws + WS_GG); float* __restrict__ DECo = (float*)(a.ws + WS_DEC);
    { const u32x4* img = (const u32x4*)(a.ws + WS_IMG + (size_t)l * IMG_LSTRIDE + IMG_RW); u32x4 r[12];
#pragma unroll
      for (int i = 0; i < 12; ++i) { const int q = tid + 512 * i; r[i] = img[q < 5888 ? q : 5887]; }
#pragma unroll
      for (int i = 0; i < 12; ++i) { const int q = tid + 512 * i; if (q < 5888) *(LAS u32x4*)(lds + q * 16) = r[i]; } }
    for (int e = tid; e < 7 * 256; e += 512) { const int v = e >> 8, c = e & 255; WT7[e] = v == 0 ? mu[c] : v == 1 ? mu[256 + c] : v == 2 ? mu[512 + c] : v == 3 ? w0[c] : v == 4 ? a0[c] : v == 5 ? kkw[c] : kaw[c]; }
    for (int tile = bid; tile < T / 64; tile += G) {
        const int t0 = tile * 64, s0 = t0 & (SEQ - 1);
        __syncthreads();
        { u32x4 cu[3], pv[3];
#pragma unroll
          for (int i = 0; i < 3; ++i) { int gi = tid + 512 * i; gi = gi < 1280 ? gi : 1279; const int tok = gi / 20, g8 = gi - tok * 20; const size_t t = (size_t)(t0 + tok);
              const bf16_t* pc = P + t * PLD + PC_B + 768 + g8 * 8; cu[i] = *(const u32x4*)pc; pv[i] = *(const u32x4*)((s0 + tok > 0) ? pc - PLD : pc); }
#pragma unroll
          for (int i = 0; i < 3; ++i) { const int gi = tid + 512 * i; if (gi < 1280) { const int tok = gi / 20, g8 = gi - tok * 20, j0 = g8 * 8; const bool hp = (s0 + tok) > 0;
              float fc[8], fp[8], ov[8]; unpack8(cu[i], fc); unpack8(pv[i], fp);
              const f32x4 m0 = *(const f32x4*)(mu + 768 + j0), m1 = *(const f32x4*)(mu + 768 + j0 + 4);
#pragma unroll
              for (int e = 0; e < 8; ++e) { const float pvv = hp ? fp[e] : 0.f; const float val = fc[e] + (e < 4 ? m0[e & 3] : m1[e & 3]) * (pvv - fc[e]);
                  const float sg = sigmoidf_(j0 < 64 ? 2.0f * val : val); ov[e] = j0 < 64 ? 2.0f * sg - 1.0f : (j0 < 96 ? val : sg); }
              u32x4 w; w.x = pk2(ov[0], ov[1]); w.y = pk2(ov[2], ov[3]); w.z = pk2(ov[4], ov[5]); w.w = pk2(ov[6], ov[7]);
              LAS bf16_t* dst = j0 < 64 ? Tw + tok * 72 + j0 : (j0 < 96 ? Ta + tok * 40 + (j0 - 64) : Tg + tok * 72 + (j0 - 96));
              *(LAS u32x4*)dst = w; } } }
        __syncthreads();
#pragma unroll 1
        for (int x = 0; x < 2; ++x) { const int task = wave * 2 + x, mt = task >> 2, h = task & 3;
            const int tok = 16 * mt + (lane & 15), t = t0 + tok, fq = lane >> 4; const bool hasprev = (s0 + tok) > 0;
            float kkr[2][8], av[2][8]; float ss = 0.f;
            u32x4 prc[2][3], prp_[2][3];
            { const bf16_t* pr0 = P + (size_t)t * PLD + PC_B + h * 64 + 8 * fq; const bf16_t* pp0 = hasprev ? pr0 - PLD : pr0;
#pragma unroll
              for (int pp = 0; pp < 2; ++pp)
#pragma unroll
                  for (int q = 0; q < 3; ++q) { prc[pp][q] = *(const u32x4*)(pr0 + pp * 32 + q * 256); prp_[pp][q] = *(const u32x4*)(pp0 + pp * 32 + q * 256); } }
#pragma unroll
            for (int pp = 0; pp < 2; ++pp) { const int n0 = h * 64 + pp * 32, col = n0 + 8 * fq; const f32x4 z = (f32x4){0.f, 0.f, 0.f, 0.f};
                const f32x4 aw0 = mma16(Tw + 16 * mt * 72, 72, WU + n0 * 72, 72, 64, lane, z), aw1 = mma16(Tw + 16 * mt * 72, 72, WU + (n0 + 16) * 72, 72, 64, lane, z);
                const f32x4 aa0 = mma16(Ta + 16 * mt * 40, 40, AU + n0 * 40, 40, 32, lane, z), aa1 = mma16(Ta + 16 * mt * 40, 40, AU + (n0 + 16) * 40, 40, 32, lane, z);
                const f32x4 ag0 = mma16(Tg + 16 * mt * 72, 72, GU + n0 * 72, 72, 64, lane, z), ag1 = mma16(Tg + 16 * mt * 72, 72, GU + (n0 + 16) * 72, 72, 64, lane, z);
                float rc[8], kc[8], vc[8], rp[8], kp[8], vp[8];
                unpack8(prc[pp][0], rc); unpack8(prc[pp][1], kc); unpack8(prc[pp][2], vc); unpack8(prp_[pp][0], rp); unpack8(prp_[pp][1], kp); unpack8(prp_[pp][2], vp);
                float r8[8], k8[8], v8[8], g8[8], d8[8];
#pragma unroll
                for (int e = 0; e < 8; ++e) {
                    const int c = col + e;
                    const float rprev = hasprev ? rp[e] : 0.f, kprev = hasprev ? kp[e] : 0.f, vprev = hasprev ? vp[e] : 0.f;
                    r8[e] = rc[e] + WT7[c] * (rprev - rc[e]);
                    const float kraw = kc[e] + WT7[256 + c] * (kprev - kc[e]);
                    v8[e] = vc[e] + WT7[512 + c] * (vprev - vc[e]);
                    const float accw = e < 4 ? aw0[e & 3] : aw1[e & 3], acca = e < 4 ? aa0[e & 3] : aa1[e & 3], accg = e < 4 ? ag0[e & 3] : ag1[e & 3];
                    const float wv = WT7[768 + c] + accw; d8[e] = __expf(-0.6065306597126334f * sigmoidf_(wv));
                    const float aa = sigmoidf_(WT7[1024 + c] + acca); av[pp][e] = aa; g8[e] = accg;
                    const float kq = kraw * WT7[1280 + c]; kkr[pp][e] = kq; ss += kq * kq;
                    k8[e] = kraw * (1.0f + (aa - 1.0f) * WT7[1536 + c]);
                }
                const size_t o = (size_t)t * 256 + col;
                u32x4 w; w.x = pk2(r8[0], r8[1]); w.y = pk2(r8[2], r8[3]); w.z = pk2(r8[4], r8[5]); w.w = pk2(r8[6], r8[7]); *(u32x4*)(Ro + o) = w;
                w.x = pk2(k8[0], k8[1]); w.y = pk2(k8[2], k8[3]); w.z = pk2(k8[4], k8[5]); w.w = pk2(k8[6], k8[7]); *(u32x4*)(Ko + o) = w;
                w.x = pk2(v8[0], v8[1]); w.y = pk2(v8[2], v8[3]); w.z = pk2(v8[4], v8[5]); w.w = pk2(v8[6], v8[7]); *(u32x4*)(Vo + o) = w;
                w.x = pk2(g8[0], g8[1]); w.y = pk2(g8[2], g8[3]); w.z = pk2(g8[4], g8[5]); w.w = pk2(g8[6], g8[7]); *(u32x4*)(Go + o) = w;
                *(f32x4*)(DECo + o) = (f32x4){d8[0], d8[1], d8[2], d8[3]}; *(f32x4*)(DECo + o + 4) = (f32x4){d8[4], d8[5], d8[6], d8[7]};
            }
            ss += __shfl_xor(ss, 16); ss += __shfl_xor(ss, 32);
            const float inv = rsqrtf(fmaxf(ss, 1e-24f));
#pragma unroll
            for (int pp = 0; pp < 2; ++pp) { const size_t o = (size_t)t * 256 + h * 64 + pp * 32 + 8 * fq;
                float q[8], qa[8];
#pragma unroll
                for (int e = 0; e < 8; ++e) { q[e] = kkr[pp][e] * inv; qa[e] = q[e] * av[pp][e]; }
                u32x4 w; w.x = pk2(q[0], q[1]); w.y = pk2(q[2], q[3]); w.z = pk2(q[4], q[5]); w.w = pk2(q[6], q[7]); *(u32x4*)(KKo + o) = w;
                w.x = pk2(qa[0], qa[1]); w.y = pk2(qa[2], qa[3]); w.z = pk2(qa[4], qa[5]); w.w = pk2(qa[6], qa[7]); *(u32x4*)(AKKo + o) = w; }
        }
    }
    __syncthreads();
}
__device__ __forceinline__ void nsa_prep_phase(const Args& a, int l, int tid, int G, int bid) {
    const bf16_t* __restrict__ P = (const bf16_t*)(a.ws + WS_P);
    const float* __restrict__ qw = INTAB(a)[20] + l * 64; const float* __restrict__ kw = INTAB(a)[21] + l * 192;
    bf16_t* __restrict__ QN = (bf16_t*)(a.ws + WS_QN); bf16_t* __restrict__ KSEL = (bf16_t*)(a.ws + WS_KSEL); bf16_t* __restrict__ VSEL = (bf16_t*)(a.ws + WS_VSEL); bf16_t* __restrict__ KWIN = (bf16_t*)(a.ws + WS_KWIN); bf16_t* __restrict__ VWIN = (bf16_t*)(a.ws + WS_VWIN);
    float* __restrict__ GATES = (float*)(a.ws + WS_GATES);
    const int sub = tid & 7, vi = (tid >> 3) & 7;
    const int scol = vi < 4 ? PC_Q + vi * 64 : (vi == 4 ? PC_KS : (vi == 5 ? PC_KW : (vi == 6 ? PC_VS : PC_VW)));
    const float* nwp = vi < 4 ? qw : (vi == 4 ? kw + 64 : kw + 128);
    const f32x4 nw0 = *(const f32x4*)(nwp + sub * 8), nw1 = *(const f32x4*)(nwp + sub * 8 + 4);
    bf16_t* dbase = vi < 4 ? QN + vi * 64 : (vi == 4 ? KSEL : (vi == 5 ? KWIN : (vi == 6 ? VSEL : VWIN)));
    const int dstride = vi < 4 ? 256 : 64;
    const float qsc = vi < 4 ? (0.125f * 1.4426950408889634f) : 1.0f;
#pragma unroll 4
    for (int t = bid * 8 + (tid >> 6); t < T; t += G * 8) {
        const u32x4 v = *(const u32x4*)(P + (size_t)t * PLD + scol + sub * 8);
        float f[8]; unpack8(v, f);
        float ss = ((f[0] * f[0] + f[1] * f[1]) + (f[2] * f[2] + f[3] * f[3])) + ((f[4] * f[4] + f[5] * f[5]) + (f[6] * f[6] + f[7] * f[7])); ss = red8(ss);
        const float sc = qsc * rsqrtf(ss * (1.0f / 64.0f) + 1e-6f);
        u32x4 w = v;
        if (vi < 6) { w.x = pk2(f[0] * sc * nw0[0], f[1] * sc * nw0[1]); w.y = pk2(f[2] * sc * nw0[2], f[3] * sc * nw0[3]); w.z = pk2(f[4] * sc * nw1[0], f[5] * sc * nw1[1]); w.w = pk2(f[6] * sc * nw1[2], f[7] * sc * nw1[3]); }
        *(u32x4*)(dbase + (size_t)t * dstride + sub * 8) = w;
    }
#pragma unroll 3
    for (int e = bid * 512 + tid; e < T * 12; e += G * 512) { const int t = e / 12, j = e - t * 12; GATES[e] = sigmoidf_(bf2f(P[(size_t)t * PLD + PC_G + j])); }
}
__device__ __forceinline__ float gelu_tanh(float x) { const float u = 0.7978845608028654f * (x + 0.044715f * x * x * x); return 0.5f * x * (1.0f + tanhf(u)); }
__device__ __forceinline__ void compress_phase(const Args& a, int l, LAS unsigned char* lds, int tid, int lane, int wave, int G, int bid) {
    const bf16_t* P = (const bf16_t*)(a.ws + WS_P);
    LAS bf16_t* KC = (LAS bf16_t*)lds;
    LAS bf16_t* VC = (LAS bf16_t*)(lds + 39168);
    LAS bf16_t* HK = (LAS bf16_t*)(lds + 78336);
    LAS bf16_t* W2 = (LAS bf16_t*)(lds + 87040);
    LAS float* OK = (LAS float*)(lds + 121856);
    LAS float* BI = (LAS float*)(lds + 125952);
    const bf16_t* WCK = (const bf16_t*)(a.ws + WS_W0 + (size_t)l * WS_LSTRIDE + WO_CK); const bf16_t* WCV = (const bf16_t*)(a.ws + WS_W0 + (size_t)l * WS_LSTRIDE + WO_CV);
    bf16_t* KCMP = (bf16_t*)(a.ws + WS_KCMP); bf16_t* VCMP = (bf16_t*)(a.ws + WS_VCMP);
    const float* knw = INTAB(a)[21] + l * 192;
    { const u32x4* img = (const u32x4*)(a.ws + WS_IMG + (size_t)l * IMG_LSTRIDE + IMG_W2); u32x4 r[5];
#pragma unroll
      for (int i = 0; i < 5; ++i) { const int q = tid + 512 * i; r[i] = img[q < 2176 ? q : 2175]; }
#pragma unroll
      for (int i = 0; i < 5; ++i) { const int q = tid + 512 * i; if (q < 2176) *(LAS u32x4*)((LAS unsigned char*)W2 + q * 16) = r[i]; } }
    if (tid < 256) { const int kv = tid >> 7, j = tid & 127; const float* cb = (const float*)(a.ws + WS_CBP) + ((l * 2 + kv) * 64) * 128 + j; float s = 0.f;
#pragma unroll 16
        for (int p = 0; p < 64; ++p) s += cb[p * 128]; BI[tid] = s; }
    for (int unit = bid; unit < 256; unit += G) {
        const int b = unit >> 5, grp = (unit >> 1) & 15, kv = unit & 1, sbase = 256 * grp;
        __syncthreads();
        { u32x4 rr[5];
#pragma unroll
          for (int i = 0; i < 5; ++i) { int pc = tid + 512 * i; pc = pc < 2176 ? pc : 2175; const int r = pc >> 3, c8 = pc & 7, sx = sbase + r; const int sc_ = sx < SEQ ? sx : SEQ - 1;
              rr[i] = *(const u32x4*)(P + (size_t)(b * SEQ + sc_) * PLD + (kv ? PC_VC : PC_KC) + c8 * 8); if (sx >= SEQ) rr[i] = (u32x4){0u, 0u, 0u, 0u}; }
#pragma unroll
          for (int i = 0; i < 5; ++i) { const int pc = tid + 512 * i; if (pc < 2176) { const int r = pc >> 3, c8 = pc & 7; *(LAS u32x4*)(KC + r * 72 + c8 * 8) = rr[i]; } } }
        __syncthreads();
        { const int nt = wave;
            const LAS bf16_t* ap = KC + 16 * (lane & 15) * 72 + 8 * (lane >> 4);
            const bf16_t* bp = (kv ? WCV : WCK) + (size_t)(nt * 16 + (lane & 15)) * 2048 + 8 * (lane >> 4);
            f32x4 acc = (f32x4){0.f, 0.f, 0.f, 0.f};
#pragma unroll 16
            for (int j = 0; j < 32; ++j) {
                const bf16x8 a0 = *(const LAS bf16x8*)(ap + j * 72), a1 = *(const LAS bf16x8*)(ap + j * 72 + 32);
                const bf16x8 b0 = *(const bf16x8*)(bp + j * 64), b1 = *(const bf16x8*)(bp + j * 64 + 32);
                acc = __builtin_amdgcn_mfma_f32_16x16x32_bf16(b0, a0, acc, 0, 0, 0);
                acc = __builtin_amdgcn_mfma_f32_16x16x32_bf16(b1, a1, acc, 0, 0, 0);
            }
            const int m = lane & 15, col = nt * 16 + 4 * (lane >> 4);
            float hv[4];
#pragma unroll
            for (int i = 0; i < 4; ++i) hv[i] = gelu_tanh(acc[i] + BI[kv * 128 + col + i]);
            u32x2 w; w.x = pk2(hv[0], hv[1]); w.y = pk2(hv[2], hv[3]);
            *(LAS u32x2*)(HK + m * 136 + col) = w;
        }
        __syncthreads();
        if (wave < 4) { const int nt2 = wave;
          const f32x4 acc = mma16(HK, 136, W2 + (kv * 64 + nt2 * 16) * 136, 136, 128, lane, (f32x4){0.f, 0.f, 0.f, 0.f});
          const int m = lane & 15, d0 = nt2 * 16 + 4 * (lane >> 4), n = 16 * grp + m;
          if (kv == 1) { u32x2 w; w.x = pk2(acc[0], acc[1]); w.y = pk2(acc[2], acc[3]); *(u32x2*)(VCMP + (size_t)(b * 256 + n) * 64 + d0) = w; }
          else *(LAS f32x4*)(OK + m * 64 + d0) = acc; }
        __syncthreads();
        if (kv == 0 && tid < 256) { const int m = tid >> 4, sub = tid & 15; const f32x4 v = *(const LAS f32x4*)(OK + m * 64 + sub * 4);
            float ss = (v[0] * v[0] + v[1] * v[1]) + (v[2] * v[2] + v[3] * v[3]); ss = red16(ss);
            const float rs = rsqrtf(ss * (1.0f / 64.0f) + 1e-6f); const float* nw = knw + sub * 4;
            u32x2 w; w.x = pk2(v[0] * rs * nw[0], v[1] * rs * nw[1]); w.y = pk2(v[2] * rs * nw[2], v[3] * rs * nw[3]);
            *(u32x2*)(KCMP + (size_t)(b * 256 + 16 * grp + m) * 64 + sub * 4) = w; }
    }
    __syncthreads();
}
constexpr int SC_CH = 32, SC_STEP = 336;
__device__ __forceinline__ void scan_phase(const Args& a, LAS unsigned char* lds, int tid, int lane, int wave, int G, int bid) {
    LAS float* OP = (LAS float*)lds;
    LAS float* VV = (LAS float*)(lds + 2 * SC_CH * SC_STEP * 4);
    LAS float* YB = VV + 2 * 512;
    const bf16_t* Rr = (const bf16_t*)(a.ws + WS_R); const bf16_t* Kr = (const bf16_t*)(a.ws + WS_K); const bf16_t* Vr = (const bf16_t*)(a.ws + WS_V);
    const bf16_t* KKr = (const bf16_t*)(a.ws + WS_KK); const bf16_t* AKKr = (const bf16_t*)(a.ws + WS_AKK); const float* DECr = (const float*)(a.ws + WS_DEC);
    float* YR = (float*)(a.ws + WS_YR);
    for (int unit = bid; unit < 128; unit += G) {
        const int b = unit >> 4, h = (unit >> 2) & 3, v0 = (unit & 3) * 16;
        const size_t tb = (size_t)b * SEQ;
        const int pst = (tid & 255) >> 3, pg8 = tid & 7, dst_ = tid >> 4, dg4 = tid & 15, vst = (tid & 63) >> 1, vhalf = tid & 1;
        const bf16_t* srcA = ((tid & 256) ? AKKr : KKr) + (tb + pst) * 256 + h * 64 + pg8 * 8;
        const bf16_t* srcB = ((tid & 256) ? Rr : Kr) + (tb + pst) * 256 + h * 64 + pg8 * 8;
        const float* srcD = DECr + (tb + dst_) * 256 + h * 64 + dg4 * 4;
        const bf16_t* srcV = Vr + (tb + vst) * 256 + h * 64 + v0 + vhalf * 8;
        const int ldA = pst * SC_STEP + ((tid & 256) ? 64 : 0) + pg8 * 8, ldB = pst * SC_STEP + ((tid & 256) ? 256 : 192) + pg8 * 8, ldD = dst_ * SC_STEP + 128 + dg4 * 4, ldV = vst * SC_STEP + 320 + vhalf * 8;
        u32x4 rA, rB, rV = (u32x4){0u, 0u, 0u, 0u}; f32x4 rD;
#define SCAN_ISSUE(CH) do { const size_t co = (size_t)(CH) * SC_CH * 256; rA = *(const u32x4*)(srcA + co); rB = *(const u32x4*)(srcB + co); rD = *(const f32x4*)(srcD + co); if (tid < 64) rV = *(const u32x4*)(srcV + co); } while (0)
#define SCAN_PUT8(dst, v) do { *(LAS f32x4*)(dst) = (f32x4){bf_lo((v).x), bf_hi((v).x), bf_lo((v).y), bf_hi((v).y)}; *(LAS f32x4*)((dst) + 4) = (f32x4){bf_lo((v).z), bf_hi((v).z), bf_lo((v).w), bf_hi((v).w)}; } while (0)
        typedef float f32x2 __attribute__((ext_vector_type(2)));
        f32x2 Sa = (f32x2){0.f, 0.f}, Sb = (f32x2){0.f, 0.f};
        const int lr = lane >> 4, c = lane & 15, row = 4 * wave + lr;
        float wsel[16];
#pragma unroll
        for (int q = 0; q < 16; ++q) wsel[q] = (c == q) ? 1.0f : 0.0f;
        SCAN_ISSUE(0);
        __syncthreads();
        for (int ch = 0; ch < SEQ / SC_CH; ++ch) {
            LAS float* buf = OP + (ch & 1) * SC_CH * SC_STEP;
            SCAN_PUT8(buf + ldA, rA); SCAN_PUT8(buf + ldB, rB); *(LAS f32x4*)(buf + ldD) = rD; if (tid < 64) { LAS float* vd = VV + (ch & 1) * 512 + (vst >> 2) * 64 + (vhalf * 8) * 4 + (vst & 3); vd[0] = bf_lo(rV.x); vd[4] = bf_hi(rV.x); vd[8] = bf_lo(rV.y); vd[12] = bf_hi(rV.y); vd[16] = bf_lo(rV.z); vd[20] = bf_hi(rV.z); vd[24] = bf_lo(rV.w); vd[28] = bf_hi(rV.w); }
            __syncthreads();
            if (ch + 1 < SEQ / SC_CH) SCAN_ISSUE(ch + 1);
            if (wave < 4) {
                const LAS float* op0 = buf + 4 * c; const LAS float* vv0 = VV + (ch & 1) * 512 + row * 4;
                f32x4 nkk = *(const LAS f32x4*)(op0), nak = *(const LAS f32x4*)(op0 + 64), nw = *(const LAS f32x4*)(op0 + 128), nk = *(const LAS f32x4*)(op0 + 192), nr = *(const LAS f32x4*)(op0 + 256);
                f32x4 nv[4] = {*(const LAS f32x4*)(vv0), *(const LAS f32x4*)(vv0 + 64), *(const LAS f32x4*)(vv0 + 128), *(const LAS f32x4*)(vv0 + 192)};
#pragma unroll 1
                for (int oh = 0; oh < 2; ++oh) {
                    const LAS float* opb = op0 + oh * 16 * SC_STEP;
                    const f32x4 vq[4] = {nv[0], nv[1], nv[2], nv[3]};
                    { const int ohn = oh < 1 ? 1 : 1;
#pragma unroll
                      for (int q = 0; q < 4; ++q) nv[q] = *(const LAS f32x4*)(vv0 + (ohn * 4 + q) * 64); }
                    float yk = 0.f;
#pragma unroll
                    for (int i = 0; i < 16; ++i) {
                        const f32x4 kk4 = nkk, ak4 = nak, w4 = nw, k4 = nk, r4 = nr; const float vv = vq[i >> 2][i & 3];
                        { const int nx = (i < 15) ? (i + 1) : (oh < 1 ? 16 : 15); const LAS float* on = opb + nx * SC_STEP;
                          nkk = *(const LAS f32x4*)(on); nak = *(const LAS f32x4*)(on + 64); nw = *(const LAS f32x4*)(on + 128); nk = *(const LAS f32x4*)(on + 192); nr = *(const LAS f32x4*)(on + 256); }
                        f32x2 t = Sa * (f32x2){kk4[0], kk4[1]}; t = __builtin_elementwise_fma(Sb, (f32x2){kk4[2], kk4[3]}, t);
                        float sa = t.x + t.y;
                        sa = allred16_dpp(sa);
                        const f32x2 nsa2 = (f32x2){-sa, -sa}, vv2 = (f32x2){vv, vv};
                        f32x2 ua = vv2 * (f32x2){k4[0], k4[1]}, ub = vv2 * (f32x2){k4[2], k4[3]};
                        ua = __builtin_elementwise_fma(nsa2, (f32x2){ak4[0], ak4[1]}, ua); ub = __builtin_elementwise_fma(nsa2, (f32x2){ak4[2], ak4[3]}, ub);
                        Sa = __builtin_elementwise_fma(Sa, (f32x2){w4[0], w4[1]}, ua); Sb = __builtin_elementwise_fma(Sb, (f32x2){w4[2], w4[3]}, ub);
                        f32x2 yy = Sa * (f32x2){r4[0], r4[1]}; yy = __builtin_elementwise_fma(Sb, (f32x2){r4[2], r4[3]}, yy);
                        float y = yy.x + yy.y;
                        y = allred16_dpp(y);
                        yk = fmaf(wsel[i], y, yk);
                    }
                    YB[(oh * 16 + c) * 16 + row] = yk;
                }
            }
            __syncthreads();
            { const int st = tid >> 4, r = tid & 15; YR[(tb + ch * SC_CH + st) * 256 + h * 64 + v0 + r] = YB[st * 16 + r]; }
        }
        __syncthreads();
    }
}
__device__ __forceinline__ void rwkv_out_phase(const Args& a, int l, int tid, int G, int bid) {
    const float* __restrict__ YR = (const float*)(a.ws + WS_YR); bf16_t* __restrict__ Y = (bf16_t*)(a.ws + WS_Y);
    const bf16_t* __restrict__ Rr = (const bf16_t*)(a.ws + WS_R); const bf16_t* __restrict__ Kr = (const bf16_t*)(a.ws + WS_K); const bf16_t* __restrict__ Vr = (const bf16_t*)(a.ws + WS_V); const bf16_t* __restrict__ Gr = (const bf16_t*)(a.ws + WS_GG);
    const float* rk = INTAB(a)[17] + l * 256; const float* lw = INTAB(a)[18] + l * 256; const float* lb = INTAB(a)[19] + l * 256;
    const int sub = tid & 7, c0 = ((tid >> 3) & 3) * 64 + sub * 8;
    const f32x4 rk0 = *(const f32x4*)(rk + c0), rk1 = *(const f32x4*)(rk + c0 + 4), lw0 = *(const f32x4*)(lw + c0), lw1 = *(const f32x4*)(lw + c0 + 4), lb0 = *(const f32x4*)(lb + c0), lb1 = *(const f32x4*)(lb + c0 + 4);
#pragma unroll 4
    for (int t = bid * 16 + (tid >> 5); t < T; t += G * 16) {
        const size_t o = (size_t)t * 256 + c0;
        const f32x4 y0 = *(const f32x4*)(YR + o), y1 = *(const f32x4*)(YR + o + 4);
        const u32x4 r4 = *(const u32x4*)(Rr + o), k4 = *(const u32x4*)(Kr + o), v4 = *(const u32x4*)(Vr + o), g4 = *(const u32x4*)(Gr + o);
        const float mean = red8(((y0[0] + y0[1]) + (y0[2] + y0[3])) + ((y1[0] + y1[1]) + (y1[2] + y1[3]))) * (1.0f / 64.0f);
        const f32x4 d0 = y0 - mean, d1 = y1 - mean;
        const float var = red8(((d0[0] * d0[0] + d0[1] * d0[1]) + (d0[2] * d0[2] + d0[3] * d0[3])) + ((d1[0] * d1[0] + d1[1] * d1[1]) + (d1[2] * d1[2] + d1[3] * d1[3]))) * (1.0f / 64.0f);
        const float rstd = rsqrtf(var + 64e-5f);
        float r[8], k[8], v[8], g[8]; unpack8(r4, r); unpack8(k4, k); unpack8(v4, v); unpack8(g4, g);
        float bs = 0.f;
#pragma unroll
        for (int i = 0; i < 8; ++i) bs += r[i] * k[i] * (i < 4 ? rk0[i & 3] : rk1[i & 3]);
        bs = red8(bs);
        float ov[8];
#pragma unroll
        for (int i = 0; i < 8; ++i) { const float dd = i < 4 ? d0[i & 3] : d1[i & 3], lwv = i < 4 ? lw0[i & 3] : lw1[i & 3], lbv = i < 4 ? lb0[i & 3] : lb1[i & 3]; ov[i] = (dd * rstd * lwv + lbv + bs * v[i]) * g[i]; }
        u32x4 w; w.x = pk2(ov[0], ov[1]); w.y = pk2(ov[2], ov[3]); w.z = pk2(ov[4], ov[5]); w.w = pk2(ov[6], ov[7]);
        *(u32x4*)(Y + (size_t)t * D + 256 + c0) = w;
    }
}
constexpr float LOG2E = 1.4426950408889634f;
constexpr int NSA_KV = 64 * 72, NSA_VS = 76, NSA_BUF = NSA_KV + 64 * NSA_VS;
template <int MODE>
__device__ __forceinline__ void attn_tiles(unsigned long long tmask, const bf16_t* __restrict__ Ksrc, const bf16_t* __restrict__ Vsrc, LAS bf16_t* KVB, LAS float* IMPh,
                                           const bf16x8 (&qf)[2][2], float (&lrow)[2], f32x4 (&o)[2][4], const unsigned long long (&selm)[2],
                                           int qi, int qbase, float slope2, float bnd, int tid, int lane, int wave) {
    const int fr = lane & 15, fq = lane >> 4;
    const int key = tid >> 3, part = tid & 7;
    if (!tmask) return;
    const u32x4 zz = (u32x4){0u, 0u, 0u, 0u};
    u32x4 k0 = zz, v0 = zz, k1 = zz, v1 = zz;
    unsigned long long lm = tmask;
#define NSA_LOAD(KR, VR) do { const int j_ = __builtin_ctzll(lm); lm &= lm - 1; KR = *(const u32x4*)(Ksrc + (size_t)(64 * j_ + key) * 64 + part * 8); VR = *(const u32x4*)(Vsrc + (size_t)(64 * j_ + key) * 64 + part * 8); } while (0)
#define NSA_PUT(BUF) do { LAS bf16_t* kt_ = KVB + (BUF) * NSA_BUF; *(LAS u32x4*)(kt_ + key * 72 + part * 8) = k0; LAS bf16_t* vp = kt_ + NSA_KV + (part * 8) * NSA_VS + key; \
        vp[0 * NSA_VS] = (bf16_t)(v0.x & 0xffffu); vp[1 * NSA_VS] = (bf16_t)(v0.x >> 16); vp[2 * NSA_VS] = (bf16_t)(v0.y & 0xffffu); vp[3 * NSA_VS] = (bf16_t)(v0.y >> 16); \
        vp[4 * NSA_VS] = (bf16_t)(v0.z & 0xffffu); vp[5 * NSA_VS] = (bf16_t)(v0.z >> 16); vp[6 * NSA_VS] = (bf16_t)(v0.w & 0xffffu); vp[7 * NSA_VS] = (bf16_t)(v0.w >> 16); } while (0)
    NSA_LOAD(k0, v0);
    if (lm) NSA_LOAD(k1, v1);
    __syncthreads();
    NSA_PUT(0); k0 = k1; v0 = v1;
    if (lm) NSA_LOAD(k1, v1);
    __syncthreads();
    int cur = 0;
    for (;;) {
        const int j = __builtin_ctzll(tmask); tmask &= tmask - 1;
        if (tmask) { NSA_PUT(cur ^ 1); k0 = k1; v0 = v1; if (lm) NSA_LOAD(k1, v1); }
        const LAS bf16_t* KT = KVB + cur * NSA_BUF; const LAS bf16_t* VT = KT + NSA_KV;
        const bool wave_active = (MODE != 2) || (__ballot((((selm[0] | selm[1]) >> j) & 1ull) != 0ull) != 0ull);
        if (wave_active) {
        constexpr int DM = (MODE == 1) ? 16 : 1;
        const float sl = slope2 * (float)DM;
        int dbase[2]; float c0[2];
#pragma unroll
        for (int mt = 0; mt < 2; ++mt) { const int sq = 64 * qi + qbase + 16 * mt + fr;
            dbase[mt] = (MODE == 1) ? sq - 31 - 1024 * j - 64 * fq : sq - 64 * j - 4 * fq;
            c0[mt] = -slope2 * (float)dbase[mt] - bnd;
            if (MODE == 2) { if (((selm[mt] >> j) & 1ull) == 0ull) c0[mt] = -1e30f; } }
        f32x4 st[2][4];
#pragma unroll
        for (int nt = 0; nt < 4; ++nt) {
            const bf16x8 k0 = *(const LAS bf16x8*)(KT + (16 * nt + fr) * 72 + 8 * fq), k1 = *(const LAS bf16x8*)(KT + (16 * nt + fr) * 72 + 32 + 8 * fq);
#pragma unroll
            for (int mt = 0; mt < 2; ++mt) {
                const f32x4 ini = (f32x4){fmaf(sl, (float)(16 * nt), c0[mt]), fmaf(sl, (float)(16 * nt + 1), c0[mt]), fmaf(sl, (float)(16 * nt + 2), c0[mt]), fmaf(sl, (float)(16 * nt + 3), c0[mt])};
                f32x4 s = __builtin_amdgcn_mfma_f32_16x16x32_bf16(k0, qf[mt][0], ini, 0, 0, 0);
                st[mt][nt] = __builtin_amdgcn_mfma_f32_16x16x32_bf16(k1, qf[mt][1], s, 0, 0, 0);
            }
        }
        const bool boundary = (MODE == 1) || (j == qi) || (MODE == 3 && j == qi - 8);
#pragma unroll
        for (int mt = 0; mt < 2; ++mt) {
            float ls = 0.f;
            if (boundary) {
#pragma unroll
                for (int nt = 0; nt < 4; ++nt)
#pragma unroll
                    for (int i = 0; i < 4; ++i) { const int dist = dbase[mt] - DM * (16 * nt + i);
                        bool valid = dist >= 0; if (MODE == 3) valid = valid && (dist < 512);
                        const float p = valid ? __builtin_amdgcn_exp2f(st[mt][nt][i]) : 0.f; st[mt][nt][i] = p; ls += p; }
            } else {
#pragma unroll
                for (int nt = 0; nt < 4; ++nt)
#pragma unroll
                    for (int i = 0; i < 4; ++i) { const float p = __builtin_amdgcn_exp2f(st[mt][nt][i]); st[mt][nt][i] = p; ls += p; }
            }
            lrow[mt] += ls;
            if (MODE == 1) {
                LAS float* ir = IMPh + (qbase + 16 * mt + fr) * 65;
#pragma unroll
                for (int nt = 0; nt < 4; ++nt) { const int jj = 16 * j + 4 * nt + fq; const f32x4 p = st[mt][nt];
                    const float c1 = (p[0] + p[1]) + (p[2] + p[3]), c2 = p[3];
                    if (c1 != 0.f) { atomicAdd((float*)(ir + jj), c1); if (jj + 1 < 64 && c2 != 0.f) atomicAdd((float*)(ir + jj + 1), c2); } }
            }
        }
#pragma unroll
        for (int ks = 0; ks < 2; ++ks) {
            bf16x8 pb[2];
#pragma unroll
            for (int mt = 0; mt < 2; ++mt) { u32x4 w; const f32x4 pa = st[mt][2 * ks], pc = st[mt][2 * ks + 1];
                w.x = pk2(pa[0], pa[1]); w.y = pk2(pa[2], pa[3]); w.z = pk2(pc[0], pc[1]); w.w = pk2(pc[2], pc[3]); pb[mt] = __builtin_bit_cast(bf16x8, w); }
#pragma unroll
            for (int dt = 0; dt < 4; ++dt) {
                const u32x2 lo = *(const LAS u32x2*)(VT + (16 * dt + fr) * NSA_VS + 32 * ks + 4 * fq), hi = *(const LAS u32x2*)(VT + (16 * dt + fr) * NSA_VS + 32 * ks + 16 + 4 * fq);
                const bf16x8 vf = __builtin_bit_cast(bf16x8, ((u32x4){lo.x, lo.y, hi.x, hi.y}));
#pragma unroll
                for (int mt = 0; mt < 2; ++mt) o[mt][dt] = __builtin_amdgcn_mfma_f32_16x16x32_bf16(vf, pb[mt], o[mt][dt], 0, 0, 0);
            }
        }
        }
        if (!tmask) break;
        __syncthreads();
        cur ^= 1;
    }
#undef NSA_LOAD
#undef NSA_PUT
}
__device__ __forceinline__ float wave_max64(float v) {
#pragma unroll
    for (int o = 1; o < 64; o <<= 1) v = fmaxf(v, __shfl_xor(v, o));
    return v;
}
__device__ __forceinline__ void nsa_unit(const Args& a, int l, int b, int qi, LAS unsigned char* lds, int tid, int lane, int wave) {
    LAS bf16_t* KVB = (LAS bf16_t*)lds;
    LAS float* IMP = (LAS float*)(lds + 37888);
    LAS unsigned long long* SELM = (LAS unsigned long long*)(lds + 104448);
    LAS float* INVL = (LAS float*)(lds + 105024);
    const bf16_t* QN = (const bf16_t*)(a.ws + WS_QN); const float* GATES = (const float*)(a.ws + WS_GATES); bf16_t* Y = (bf16_t*)(a.ws + WS_Y);
    const int fr = lane & 15, fq = lane >> 4, h = wave >> 1, qbase = (wave & 1) * 32;
    const size_t t0 = (size_t)b * SEQ + 64 * qi;
    const float slope2 = LOG2E * exp2f(-2.0f * (float)(h + 1));
    const float qmx = wave_max64(fabsf(INTAB(a)[20][l * 64 + lane]));
    const float bnd0 = 11.72f * qmx * wave_max64(fabsf(INTAB(a)[21][l * 192 + lane])), bnd1 = 11.72f * qmx * wave_max64(fabsf(INTAB(a)[21][l * 192 + 64 + lane])), bnd2 = 11.72f * qmx * wave_max64(fabsf(INTAB(a)[21][l * 192 + 128 + lane]));
    bf16x8 qf[2][2]; float gate[2][3];
#pragma unroll
    for (int mt = 0; mt < 2; ++mt) { const size_t t = t0 + qbase + 16 * mt + fr;
#pragma unroll
        for (int ks = 0; ks < 2; ++ks) qf[mt][ks] = *(const bf16x8*)(QN + t * 256 + h * 64 + 32 * ks + 8 * fq);
#pragma unroll
        for (int br = 0; br < 3; ++br) gate[mt][br] = GATES[t * 12 + h * 3 + br]; }
    for (int e = tid; e < 4 * 64 * 65; e += 512) IMP[e] = 0.f;
    f32x4 o[2][4]; LAS f32x4* OACC = (LAS f32x4*)IMP + tid; float lrow[2]; unsigned long long selm[2] = {0ull, 0ull};
    const f32x4 z4 = (f32x4){0.f, 0.f, 0.f, 0.f};
#pragma unroll
    for (int mt = 0; mt < 2; ++mt)
#pragma unroll
        for (int dt = 0; dt < 4; ++dt) o[mt][dt] = z4;
    const bf16_t* KC = (const bf16_t*)(a.ws + WS_KCMP) + (size_t)b * 256 * 64; const bf16_t* VC = (const bf16_t*)(a.ws + WS_VCMP) + (size_t)b * 256 * 64;
    const int ncmp = (4 * qi + 2) / 64 + 1; const unsigned long long cmask = (1ull << ncmp) - 1ull;
    lrow[0] = lrow[1] = 0.f;
    attn_tiles<1>(cmask, KC, VC, KVB, IMP + h * (64 * 65), qf, lrow, o, selm, qi, qbase, slope2, bnd0, tid, lane, wave);
#pragma unroll
    for (int mt = 0; mt < 2; ++mt) { float lt = lrow[mt]; lt += __shfl_xor(lt, 16); lt += __shfl_xor(lt, 32); const float il = lt > 0.f ? 1.0f / lt : 0.f;
        if (fq == 0) INVL[h * 64 + qbase + 16 * mt + fr] = il;
#pragma unroll
        for (int dt = 0; dt < 4; ++dt) o[mt][dt] = o[mt][dt] * (gate[mt][0] * il); }
    __syncthreads();
    {
        unsigned long long uni = 0ull;
        for (int qq = 0; qq < 8; ++qq) { const int q = wave * 8 + qq, j = lane;
            const float v = (IMP[q * 65 + j] * INVL[q] + IMP[4160 + q * 65 + j] * INVL[64 + q]) + (IMP[8320 + q * 65 + j] * INVL[128 + q] + IMP[12480 + q * 65 + j] * INVL[192 + q]);
            const bool forced = (j == 0) || (j == qi) || (j == qi - 1);
            const float val = (j <= qi) ? v + (forced ? 1e4f : 0.f) : -1.0f;
            const unsigned ub = __float_as_uint(val), key = (ub & 0x80000000u) ? ~ub : (ub | 0x80000000u);
            unsigned prefix = 0u;
#pragma unroll
            for (int bit = 31; bit >= 0; --bit) { const unsigned cand = prefix | (1u << bit); if (__builtin_popcountll(__ballot(key >= cand)) >= 16) prefix = cand; }
            const unsigned long long gtm = __ballot(key > prefix), eqm = __ballot(key == prefix);
            const int need = 16 - __builtin_popcountll(gtm);
            const bool pick = (key > prefix) || (key == prefix && __builtin_popcountll(eqm & ((1ull << lane) - 1ull)) < need);
            unsigned long long m = __ballot(pick);
            m &= (qi == 63) ? ~0ull : ((1ull << (qi + 1)) - 1ull);
            if (lane == 0) SELM[q] = m;
            uni |= m; }
        if (lane == 0) SELM[64 + wave] = uni;
    }
    __syncthreads();
    unsigned long long uni = 0ull;
#pragma unroll
    for (int w = 0; w < 8; ++w) uni |= SELM[64 + w];
    uni = ((unsigned long long)__builtin_amdgcn_readfirstlane((unsigned)(uni >> 32)) << 32) | (unsigned long long)__builtin_amdgcn_readfirstlane((unsigned)uni);
    selm[0] = SELM[qbase + fr]; selm[1] = SELM[qbase + 16 + fr];
#pragma unroll
    for (int mt = 0; mt < 2; ++mt)
#pragma unroll
        for (int dt = 0; dt < 4; ++dt) { OACC[(mt * 4 + dt) * 512] = o[mt][dt]; o[mt][dt] = z4; }
    lrow[0] = lrow[1] = 0.f;
    attn_tiles<2>(uni, (const bf16_t*)(a.ws + WS_KSEL) + (size_t)b * SEQ * 64, (const bf16_t*)(a.ws + WS_VSEL) + (size_t)b * SEQ * 64, KVB, IMP, qf, lrow, o, selm, qi, qbase, slope2, bnd1, tid, lane, wave);
#pragma unroll
    for (int mt = 0; mt < 2; ++mt) { float lt = lrow[mt]; lt += __shfl_xor(lt, 16); lt += __shfl_xor(lt, 32); const float sc = lt > 0.f ? gate[mt][1] / lt : 0.f;
#pragma unroll
        for (int dt = 0; dt < 4; ++dt) { OACC[(mt * 4 + dt) * 512] = OACC[(mt * 4 + dt) * 512] + o[mt][dt] * sc; o[mt][dt] = z4; } }
    const int jlo = qi >= 8 ? qi - 8 : 0;
    const unsigned long long wmask = ((qi == 63) ? ~0ull : ((1ull << (qi + 1)) - 1ull)) & ~((1ull << jlo) - 1ull);
    lrow[0] = lrow[1] = 0.f;
    attn_tiles<3>(wmask, (const bf16_t*)(a.ws + WS_KWIN) + (size_t)b * SEQ * 64, (const bf16_t*)(a.ws + WS_VWIN) + (size_t)b * SEQ * 64, KVB, IMP, qf, lrow, o, selm, qi, qbase, slope2, bnd2, tid, lane, wave);
#pragma unroll
    for (int mt = 0; mt < 2; ++mt) { float lt = lrow[mt]; lt += __shfl_xor(lt, 16); lt += __shfl_xor(lt, 32); const float sc = lt > 0.f ? gate[mt][2] / lt : 0.f;
        const size_t t = t0 + qbase + 16 * mt + fr;
#pragma unroll
        for (int dt = 0; dt < 4; ++dt) { const f32x4 r = OACC[(mt * 4 + dt) * 512] + o[mt][dt] * sc;
            u32x2 w; w.x = pk2(r[0], r[1]); w.y = pk2(r[2], r[3]);
            *(u32x2*)(Y + t * D + 512 + h * 64 + 16 * dt + 4 * fq) = w; } }
    __syncthreads();
}
__device__ __forceinline__ void nsa_phase(const Args& a, int l, int qslot, LAS unsigned char* lds, int tid, int lane, int wave) {
    unsigned* ctr = (unsigned*)(a.ws + WS_CTL) + 64 * qslot;
    LAS int* slot = (LAS int*)(lds + 106048);
    for (;;) {
        if (tid == 0) slot[0] = (int)atomicAdd(ctr, 1u);
        __syncthreads();
        const int u = slot[0];
        __syncthreads();
        if (u >= 512) break;
        const int b = u & 7, qi = 63 - (u >> 3);
        nsa_unit(a, l, b, qi, lds, tid, lane, wave);
    }
}
#ifndef PHM
#define PHM 0xffff
#endif
#ifndef DUP
#define DUP 0
#endif
#define REP(bit) if (rep_ == 0 || ((DUP >> (bit)) & 1))
__global__ void __launch_bounds__(512) mk_fwd(Args a) {
    extern __shared__ __attribute__((aligned(16))) unsigned char lds_raw[];
    LAS unsigned char* lds = (LAS unsigned char*)lds_raw;
#define OPQ() int tid = threadIdx.x; asm volatile("" : "+v"(tid)); const int lane = tid & 63, wave = __builtin_amdgcn_readfirstlane(tid >> 6); int bid = blockIdx.x; asm volatile("" : "+s"(bid)); int G = gridDim.x; asm volatile("" : "+s"(G));
    unsigned char* ws = a.ws;
    bf16_t* XB = (bf16_t*)(ws + WS_XB); bf16_t* H = (bf16_t*)(ws + WS_H); bf16_t* P = (bf16_t*)(ws + WS_P); bf16_t* Y = (bf16_t*)(ws + WS_Y); float* SSQ = (float*)(ws + WS_SSQ);
    volatile LAS unsigned* bst = (volatile LAS unsigned*)(lds + 147392);
    if (threadIdx.x < 2) bst[threadIdx.x] = 0u;
    __syncthreads();
#if MK_COOP
    XcdBarrier xbar = xcd_barrier_post((unsigned*)(a.ws + WS_BAR), bst);
    if (a.hi > 4096) cg::this_grid().sync();
#else
    XcdBarrier xbar; xbar.bar = (unsigned*)(a.ws + WS_BAR); xbar.x = 0; xbar.st = bst;
#endif
    for (int it = 2 * a.lo; it < 2 * a.hi; ++it) {
        const int ph = it >> 1, rep_ = it & 1;
        if (rep_) { const int s_ = ph == 0 ? -1 : (ph - 1) % 9; const int bits = ph == 0 ? 1 : (s_ == 0 || s_ == 7) ? 2 : s_ == 2 ? 8 : s_ == 3 ? 0x1f0 : s_ == 4 ? 0x600 : s_ == 5 ? 0x800 : 0; if (!(DUP & bits)) continue; }
        OPQ();
        if (ph == 0) { if (PHM & 1) REP(0) prologue(a, lds, tid, lane, wave, G, bid, rep_); }
        else {
            const int l = (ph - 1) / 9, s = (ph - 1) % 9;
            unsigned char* wb = ws + WS_W0 + (size_t)l * WS_LSTRIDE;
            if ((PHM & 2) && (s == 0 || s == 7)) { {
                pg8::Gemm g{XB, (const bf16_t*)(wb + (s == 0 ? WO_F1 : WO_F2)), T, NGU, D}; pg8::StaticOrder S; S.init(T, NGU, G, bid);
                pg8::EpiGU E{H, SSQ, FF};
                pg8::gemm_phase<pg8::EpiGU, pg8::StaticOrder, true, true>(lds, g, S, E); }
            } else if ((PHM & 4) && (s == 1 || s == 8)) {
                pg8::Gemm g{H, (const bf16_t*)(wb + (s == 1 ? WO_D1 : WO_D2)), T, D, FF}; pg8::StaticOrder S; S.init(T, D, G, bid);
                pg8::EpiRes E{(l == 0 && s == 1) ? a.in[0] : a.out, a.out, XB, SSQ, 0.5f};
                pg8::gemm_phase<pg8::EpiRes, pg8::StaticOrder, true, true>(lds, g, S, E);
            } else if ((PHM & 4) && s == 6) {
                pg8::Gemm g{Y, (const bf16_t*)(wb + WO_OUT), T, D, D}; pg8::StaticOrder S; S.init(T, D, G, bid);
                pg8::EpiRes E{a.out, a.out, XB, SSQ, 1.0f};
                pg8::gemm_phase<pg8::EpiRes, pg8::StaticOrder, true, true>(lds, g, S, E);
            } else if ((PHM & 8) && s == 2) { {
                pg8::Gemm g{XB, (const bf16_t*)(wb + WO_IN), T, PLD, D}; pg8::StaticOrder S; S.init(T, PLD, G, bid);
                pg8::EpiP E{P, SSQ, PLD};
                pg8::gemm_phase<pg8::EpiP, pg8::StaticOrder, true, true>(lds, g, S, E); }
            } else if (s == 3) {
                if (PHM & 16) REP(4) { OPQ(); pool_phase(a, l, lds, tid, lane, wave, G, bid); }
                if (PHM & 32) REP(5) { OPQ(); conv_phase(a, l, tid, G, bid); }
                if (PHM & 64) REP(6) { OPQ(); rwkv_prep_phase(a, l, lds, tid, lane, wave, G, bid); }
                if (PHM & 128) REP(7) { OPQ(); nsa_prep_phase(a, l, tid, G, bid); }
                if (PHM & 256) REP(8) { OPQ(); compress_phase(a, l, lds, tid, lane, wave, G, bid); }
            } else if (s == 4) {
                if (PHM & 512) REP(9) { OPQ(); scan_phase(a, lds, tid, lane, wave, G, bid); }
                if (PHM & 1024) REP(10) { OPQ(); nsa_phase(a, l, l * 2 + rep_, lds, tid, lane, wave); }
            } else if (s == 5) {
                if (PHM & 2048) REP(11) rwkv_out_phase(a, l, tid, G, bid);
            }
        }
        if (ph + 1 < a.hi) {
            xcd_barrier(xbar);
        }
    }
}

extern "C" void kernel_launch(void* const* d_in, const int* in_sizes, int n_in, void* d_out, int out_size, void* d_ws, size_t ws_size, hipStream_t stream) {
    static int grid = 0;
    if (grid == 0) {
        if (n_in != 33 || out_size != T * D || ws_size < WS_END) { fprintf(stderr, "kernel_launch: unexpected sizes n_in %d out %d ws %zu\n", n_in, out_size, ws_size); grid = -1; return; }
        int dev = 0, cus = 0, per_cu = 0;
        hipGetDevice(&dev); hipDeviceGetAttribute(&cus, hipDeviceAttributeMultiprocessorCount, dev);
        hipFuncSetAttribute((const void*)mk_fwd, hipFuncAttributeMaxDynamicSharedMemorySize, LDS_BYTES);
        if (hipOccupancyMaxActiveBlocksPerMultiprocessor(&per_cu, (const void*)mk_fwd, 512, LDS_BYTES) != hipSuccess || per_cu < 1) per_cu = 1;
        (void)hipGetLastError();
        grid = cus * per_cu;
    }
    if (grid < 0) return;
    Args a{};
    for (int i = 0; i < 33; ++i) a.in[i] = (const float*)d_in[i];
    a.out = (float*)d_out; a.ws = (unsigned char*)d_ws;
#if MK_COOP
    a.lo = 0; a.hi = NPH;
    if (hipMemsetAsync((char*)d_ws + WS_BAR, 0, XCD_BAR_WORDS * 4, stream) != hipSuccess) fprintf(stderr, "barrier memset failed\n");
    void* args[] = {&a};
    hipError_t e = hipLaunchCooperativeKernel((const void*)mk_fwd, dim3(grid), dim3(512), args, LDS_BYTES, stream);
    if (e != hipSuccess) fprintf(stderr, "cooperative launch failed: %s (grid %d)\n", hipGetErrorString(e), grid);
#else
    for (int ph = 0; ph < NPH; ++ph) { a.lo = ph; a.hi = ph + 1; hipLaunchKernelGGL(mk_fwd, dim3(grid), dim3(512), LDS_BYTES, stream, a); }
#endif
}
```

```cpp
#include <hip/hip_runtime.h>
#include <hip/hip_cooperative_groups.h>
#include <cstdio>
#include <cstdint>
namespace cg = cooperative_groups;
#ifndef MK_COOP
#define MK_COOP 1
#endif
namespace pg8 {
#define PG8_LAS __attribute__((address_space(3)))
typedef unsigned short bf16_t;
typedef short bf16x8 __attribute__((ext_vector_type(8)));
typedef float f32x4 __attribute__((ext_vector_type(4)));
typedef unsigned u32x4 __attribute__((ext_vector_type(4)));
constexpr int BM = 256, BK = 64, HALF = 128, HTB = HALF * BK * 2  , STAGE_BYTES = 8 * HTB, NXCD = 8, WGM = 8;

__host__ __device__ __forceinline__ int lds_byte(int r, int c) { const int st = (r >> 4) * 2 + (c >> 5), rr = r & 15, cc = c & 31, ob = rr * 64 + cc * 2; return st * 1024 + (ob ^ (((ob >> 9) & 1) << 5)); }
__host__ __device__ __forceinline__ void stage_rc(int b, int& R, int& C) { const int st = b / 1024, sb = b % 1024, swz = sb ^ (((sb >> 9) & 1) << 5); R = (st >> 1) * 16 + swz / 64; C = (st & 1) * 32 + (swz % 64) / 2; }
__host__ __device__ __forceinline__ int perm32(int rho) { const int n = rho >> 4, i = rho & 15; return 8 * (i >> 2) + 4 * n + (i & 3); }

struct Unit { int pm, pn; };
struct Gemm { const bf16_t* A; const bf16_t* Bt; int M, N, K; };

struct StaticOrder {
    int nM, nN, nwg, G, c;
    __host__ __device__ void init(int M, int N, int G_, int c_) { nM = M / BM; nN = N / BM; nwg = nM * nN; G = G_; c = c_; }
    __host__ __device__ bool next(int i, Unit& u) const {
        const long L = (long)i * G + c; if (L >= nwg) return false;
        int wgid = (int)L; { const int q = nwg / NXCD, r = nwg % NXCD, xcd = wgid % NXCD, off = wgid / NXCD; wgid = (xcd < r ? xcd * (q + 1) : r * (q + 1) + (xcd - r) * q) + off; }
        const int nig = WGM * nN, gid = wgid / nig, fm = gid * WGM, gsz = (nM - fm) < WGM ? (nM - fm) : WGM;
        u.pm = fm + ((wgid % nig) % gsz); u.pn = (wgid % nig) / gsz; return true;
    }
    __device__ __forceinline__ void a_ready(const Unit&) const {}
    __device__ __forceinline__ void done(const Unit&) const {}
};

__device__ __forceinline__ unsigned cvt_pk_bf16(float lo, float hi) { unsigned r; asm volatile("v_cvt_pk_bf16_f32 %0, %1, %2" : "=v"(r) : "v"(lo), "v"(hi)); return r; }
typedef float f32x2 __attribute__((ext_vector_type(2)));
__device__ __forceinline__ float row_rs(const float* ssq, int row, int fq) {
    const f32x4 s4 = *(const f32x4*)(ssq + (size_t)row * 16 + 4 * fq);
    float s = (s4[0] + s4[1]) + (s4[2] + s4[3]);
    s += __shfl_xor(s, 16); s += __shfl_xor(s, 32);
    return rsqrtf(s * (1.0f / 1024.0f) + 1e-6f);
}
__device__ __forceinline__ void row_rs8(const float* __restrict__ ssq, int row0, int fq, float (&rs)[2][4]) {
    f32x4 s4[2][4];
#pragma unroll
    for (int ai = 0; ai < 2; ++ai)
#pragma unroll
        for (int m = 0; m < 4; ++m) s4[ai][m] = *(const f32x4*)(ssq + (size_t)(row0 + ai * HALF + m * 16) * 16 + 4 * fq);
#pragma unroll
    for (int ai = 0; ai < 2; ++ai)
#pragma unroll
        for (int m = 0; m < 4; ++m) { float s = (s4[ai][m][0] + s4[ai][m][1]) + (s4[ai][m][2] + s4[ai][m][3]); s += __shfl_xor(s, 16); s += __shfl_xor(s, 32); rs[ai][m] = rsqrtf(s * (1.0f / 1024.0f) + 1e-6f); }
}
struct EpiGU {
    static constexpr bool PERM = true, AFTER_DRAIN = false;
    bf16_t* H; const float* ssq; int ldh;
    __device__ __forceinline__ void operator()(const f32x4 (&acc)[2][2][4][2], const Unit& u, int wr, int wc, int fr, int fq) const {
        float rs8[2][4]; row_rs8(ssq, u.pm * BM + wr * 64 + fr, fq, rs8);
#pragma unroll
        for (int ai = 0; ai < 2; ++ai)
#pragma unroll
            for (int m = 0; m < 4; ++m) {
                const int row = u.pm * BM + ai * HALF + wr * 64 + m * 16 + fr;
                const float rs = rs8[ai][m], rsl = -1.4426950408889634f * rs, rs2 = rs * rs;
                float hv[8];
#pragma unroll
                for (int n = 0; n < 2; ++n) {
                    const f32x4 ag = acc[ai][0][m][n], au = acc[ai][1][m][n];
                    const f32x4 ea = ag * rsl, gu = (ag * au) * rs2;
#pragma unroll
                    for (int j = 0; j < 4; ++j) hv[4 * n + j] = gu[j] * __builtin_amdgcn_rcpf(1.0f + __builtin_amdgcn_exp2f(ea[j]));
                }
                u32x4 w; w.x = cvt_pk_bf16(hv[0], hv[1]); w.y = cvt_pk_bf16(hv[2], hv[3]); w.z = cvt_pk_bf16(hv[4], hv[5]); w.w = cvt_pk_bf16(hv[6], hv[7]);
                *(u32x4*)(H + (size_t)row * ldh + u.pn * 128 + wc * 32 + 8 * fq) = w;
            }
    }
};
struct EpiRes {
    static constexpr bool PERM = true, AFTER_DRAIN = false;
    const float* Xin; float* X; bf16_t* XB; float* ssq; float alpha;
    __device__ __forceinline__ void operator()(const f32x4 (&acc)[2][2][4][2], const Unit& u, int wr, int wc, int fr, int fq) const {
        const size_t base = (size_t)(u.pm * BM + wr * 64 + fr) * 1024 + u.pn * BM + wc * 32 + 8 * fq;
#pragma unroll
        for (int ai = 0; ai < 2; ++ai) {
            f32x4 xv[4][2][2];
#pragma unroll
            for (int m = 0; m < 4; ++m)
#pragma unroll
                for (int bj = 0; bj < 2; ++bj)
#pragma unroll
                    for (int n = 0; n < 2; ++n) xv[m][bj][n] = *(const f32x4*)(Xin + base + (size_t)(ai * HALF + m * 16) * 1024 + bj * HALF + n * 4);
            asm volatile("" ::: "memory");
#pragma unroll
            for (int m = 0; m < 4; ++m) {
                float ss = 0.f;
#pragma unroll
                for (int bj = 0; bj < 2; ++bj) {
                    const size_t off = base + (size_t)(ai * HALF + m * 16) * 1024 + bj * HALF;
                    const f32x4 x0 = xv[m][bj][0] + acc[ai][bj][m][0] * alpha, x1 = xv[m][bj][1] + acc[ai][bj][m][1] * alpha;
                    *(f32x4*)(X + off) = x0; *(f32x4*)(X + off + 4) = x1;
                    u32x4 w; w.x = cvt_pk_bf16(x0[0], x0[1]); w.y = cvt_pk_bf16(x0[2], x0[3]); w.z = cvt_pk_bf16(x1[0], x1[1]); w.w = cvt_pk_bf16(x1[2], x1[3]);
                    *(u32x4*)(XB + off) = w;
                    ss += ((x0[0] * x0[0] + x0[1] * x0[1]) + (x0[2] * x0[2] + x0[3] * x0[3])) + ((x1[0] * x1[0] + x1[1] * x1[1]) + (x1[2] * x1[2] + x1[3] * x1[3]));
                }
                ss += __shfl_xor(ss, 16); ss += __shfl_xor(ss, 32);
                if (fq == 0) ssq[(size_t)(u.pm * BM + ai * HALF + wr * 64 + m * 16 + fr) * 16 + u.pn * 4 + wc] = ss;
            }
        }
    }
};
struct EpiP {
    static constexpr bool PERM = true, AFTER_DRAIN = false;
    bf16_t* P; const float* ssq; int ldp;
    __device__ __forceinline__ void operator()(const f32x4 (&acc)[2][2][4][2], const Unit& u, int wr, int wc, int fr, int fq) const {
        float rs8[2][4]; row_rs8(ssq, u.pm * BM + wr * 64 + fr, fq, rs8);
#pragma unroll
        for (int ai = 0; ai < 2; ++ai)
#pragma unroll
            for (int m = 0; m < 4; ++m) {
                const int row = u.pm * BM + ai * HALF + wr * 64 + m * 16 + fr;
                const float rs = rs8[ai][m];
#pragma unroll
                for (int bj = 0; bj < 2; ++bj) {
                    const f32x4 v0 = acc[ai][bj][m][0] * rs, v1 = acc[ai][bj][m][1] * rs;
                    u32x4 w; w.x = cvt_pk_bf16(v0[0], v0[1]); w.y = cvt_pk_bf16(v0[2], v0[3]); w.z = cvt_pk_bf16(v1[0], v1[1]); w.w = cvt_pk_bf16(v1[2], v1[3]);
                    *(u32x4*)(P + (size_t)row * ldp + u.pn * BM + bj * HALF + wc * 32 + 8 * fq) = w;
                }
            }
    }
};
template <class Epi, class Sched, bool ALIGN_EPI = false, bool SP2 = false>
__device__ __forceinline__ void gemm_phase(PG8_LAS unsigned char* lds, const Gemm g, const Sched& S, const Epi& E) {
    int tid = threadIdx.x; asm volatile("" : "+v"(tid));
    const int wid = __builtin_amdgcn_readfirstlane(tid >> 6), lane = tid & 63, wr = wid >> 2, wc = wid & 3, fr = lane & 15, fq = lane >> 4;
    const int K = g.K, nt = K / BK;
    unsigned voffA[2], voffB[2];
#pragma unroll
    for (int i = 0; i < 2; ++i) { int R, C; stage_rc(tid * 16 + i * 8192, R, C); const int Rb = Epi::PERM ? ((R & ~31) + perm32(R & 31)) : R;
        voffA[i] = (unsigned)(R * K + C) * 2u; voffB[i] = (unsigned)(Rb * K + C) * 2u; }
    const size_t kstep = (size_t)(BK * 2);
    const size_t hstep = (size_t)HALF * K * 2;
    const size_t tstep = 2 * hstep;
    const unsigned ldsw = (unsigned)wid * 1024u;
    const int aoff = lds_byte(wr * 64 + fr, fq * 8), boff = lds_byte(wc * 32 + fr, fq * 8);
#define PG8_SA(b, h) (((b) * 2 + (h)) * HTB)
#define PG8_SB(b, h) ((4 + (b) * 2 + (h)) * HTB)
#define PG8_STAGE(bufoff, gbase, voff) do { _Pragma("unroll") for (int _i = 0; _i < 2; ++_i) \
        __builtin_amdgcn_global_load_lds((const unsigned*)((const char*)(gbase) + (voff)[_i]), (PG8_LAS unsigned*)(lds + (bufoff) + ldsw + _i * 8192), 16, 0, 0); } while (0)
#define PG8_LDA(dst, b, h) do { _Pragma("unroll") for (int m = 0; m < 4; ++m) _Pragma("unroll") for (int k = 0; k < 2; ++k) dst[m][k] = *(const PG8_LAS bf16x8*)(lds + PG8_SA(b, h) + aoff + m * 2048 + k * 1024); } while (0)
#define PG8_LDB(dst, b, h) do { _Pragma("unroll") for (int n = 0; n < 2; ++n) _Pragma("unroll") for (int k = 0; k < 2; ++k) dst[n][k] = *(const PG8_LAS bf16x8*)(lds + PG8_SB(b, h) + boff + n * 2048 + k * 1024); } while (0)
#define PG8_MMA(ai, bj, At, Bt) do { __builtin_amdgcn_s_setprio(1); _Pragma("unroll") for (int m = 0; m < 4; ++m) _Pragma("unroll") for (int n = 0; n < 2; ++n) _Pragma("unroll") for (int k = 0; k < 2; ++k) \
        acc[ai][bj][m][n] = __builtin_amdgcn_mfma_f32_16x16x32_bf16(Bt[n][k], At[m][k], acc[ai][bj][m][n], 0, 0, 0); __builtin_amdgcn_s_setprio(0); } while (0)
#define PG8_WAIT_V(n) asm volatile("s_waitcnt vmcnt(" #n ")" ::: "memory")
#define PG8_WAIT_L(n) asm volatile("s_waitcnt lgkmcnt(" #n ")" ::: "memory")
#define PG8_BAR __builtin_amdgcn_s_barrier()
#define PG8_SCHED __builtin_amdgcn_sched_barrier(0)
    Unit cur, nxt; int ui = 0;
    if (!S.next(0, cur)) return;
    f32x4 acc[2][2][4][2];
#pragma unroll
    for (int a = 0; a < 2; ++a)
#pragma unroll
        for (int b = 0; b < 2; ++b)
#pragma unroll
            for (int m = 0; m < 4; ++m)
#pragma unroll
                for (int n = 0; n < 2; ++n) acc[a][b][m][n] = (f32x4){0.f, 0.f, 0.f, 0.f};
    bf16x8 At[4][2], B0[2][2], B1[2][2];
    const char* cA = (const char*)g.A + (size_t)cur.pm * tstep; const char* cB = (const char*)g.Bt + (size_t)cur.pn * tstep;
    S.a_ready(cur);
    if constexpr (SP2) {
        PG8_STAGE(PG8_SB(0, 0), cB, voffB); PG8_STAGE(PG8_SB(0, 1), cB + hstep, voffB); PG8_STAGE(PG8_SA(0, 0), cA, voffA); PG8_STAGE(PG8_SA(0, 1), cA + hstep, voffA);
        if (wr == 1) PG8_BAR;
        PG8_WAIT_V(2); PG8_BAR;
        PG8_STAGE(PG8_SB(1, 0), cB + kstep, voffB); PG8_STAGE(PG8_SA(1, 0), cA + kstep, voffA); PG8_STAGE(PG8_SB(1, 1), cB + hstep + kstep, voffB);
        PG8_WAIT_V(6); PG8_BAR;
    } else {
        PG8_STAGE(PG8_SB(0, 0), cB, voffB); PG8_STAGE(PG8_SA(0, 0), cA, voffA); PG8_STAGE(PG8_SB(0, 1), cB + hstep, voffB); PG8_STAGE(PG8_SA(0, 1), cA + hstep, voffA);
        if (wr == 1) PG8_BAR;
        PG8_WAIT_V(4); PG8_BAR;
        PG8_STAGE(PG8_SB(1, 0), cB + kstep, voffB); PG8_STAGE(PG8_SA(1, 0), cA + kstep, voffA); PG8_STAGE(PG8_SB(1, 1), cB + hstep + kstep, voffB);
        PG8_WAIT_V(6); PG8_BAR;
    }
    for (;;) {
        const bool has_next = S.next(ui + 1, nxt);
        const char* nA = has_next ? (const char*)g.A + (size_t)nxt.pm * tstep : cA; const char* nB = has_next ? (const char*)g.Bt + (size_t)nxt.pn * tstep : cB;
        for (int t = 0; t < nt; t += 2) {
            const bool last = (t == nt - 2);
            const char* a1 = cA + (size_t)(t + 1) * kstep;
            const char* a2 = last ? nA : cA + (size_t)(t + 2) * kstep; const char* b2 = last ? nB : cB + (size_t)(t + 2) * kstep;
            const char* a3 = a2 + kstep; const char* b3 = b2 + kstep;
            if (last && has_next) S.a_ready(nxt);
            if constexpr (SP2) {
            PG8_LDB(B0, 0, 0); PG8_LDB(B1, 0, 1); PG8_SCHED; PG8_LDA(At, 0, 0); PG8_STAGE(PG8_SA(1, 1), a1 + hstep, voffA);
            PG8_WAIT_V(8); PG8_WAIT_L(0); PG8_BAR; PG8_MMA(0, 0, At, B0); PG8_MMA(0, 1, At, B1); PG8_BAR; PG8_SCHED;
            PG8_LDA(At, 0, 1); PG8_STAGE(PG8_SB(0, 0), b2, voffB); PG8_STAGE(PG8_SB(0, 1), b2 + hstep, voffB); PG8_STAGE(PG8_SA(0, 0), a2, voffA);
            PG8_WAIT_V(8); PG8_WAIT_L(0); PG8_BAR; PG8_MMA(1, 0, At, B0); PG8_MMA(1, 1, At, B1); PG8_BAR; PG8_SCHED;
            PG8_LDB(B0, 1, 0); PG8_LDB(B1, 1, 1); PG8_SCHED; PG8_LDA(At, 1, 0); PG8_STAGE(PG8_SA(0, 1), a2 + hstep, voffA);
            PG8_WAIT_V(8); PG8_WAIT_L(0); PG8_BAR; PG8_MMA(0, 0, At, B0); PG8_MMA(0, 1, At, B1); PG8_BAR; PG8_SCHED;
            PG8_LDA(At, 1, 1); PG8_STAGE(PG8_SB(1, 0), b3, voffB); PG8_STAGE(PG8_SB(1, 1), b3 + hstep, voffB); PG8_STAGE(PG8_SA(1, 0), a3, voffA);
            PG8_WAIT_V(8); PG8_WAIT_L(0); PG8_BAR; PG8_MMA(1, 0, At, B0); PG8_MMA(1, 1, At, B1); PG8_BAR; PG8_SCHED;
            } else {
            PG8_LDB(B0, 0, 0); PG8_SCHED; PG8_LDA(At, 0, 0); PG8_STAGE(PG8_SA(1, 1), a1 + hstep, voffA);
            PG8_WAIT_L(8); PG8_BAR; PG8_WAIT_L(0); PG8_MMA(0, 0, At, B0); PG8_BAR; PG8_SCHED;
            PG8_LDB(B1, 0, 1); PG8_STAGE(PG8_SB(0, 0), b2, voffB);
            PG8_BAR; PG8_WAIT_L(0); PG8_MMA(0, 1, At, B1); PG8_BAR;
            PG8_LDA(At, 0, 1); PG8_STAGE(PG8_SA(0, 0), a2, voffA);
            PG8_BAR; PG8_WAIT_L(0); PG8_MMA(1, 0, At, B0); PG8_BAR; PG8_SCHED;
            PG8_STAGE(PG8_SB(0, 1), b2 + hstep, voffB);
            PG8_WAIT_V(6); PG8_BAR; PG8_MMA(1, 1, At, B1); PG8_BAR;
            PG8_LDB(B0, 1, 0); PG8_SCHED; PG8_LDA(At, 1, 0); PG8_STAGE(PG8_SA(0, 1), a2 + hstep, voffA);
            PG8_WAIT_L(8); PG8_BAR; PG8_WAIT_L(0); PG8_MMA(0, 0, At, B0); PG8_BAR; PG8_SCHED;
            PG8_LDB(B1, 1, 1); PG8_STAGE(PG8_SB(1, 0), b3, voffB);
            PG8_BAR; PG8_WAIT_L(0); PG8_MMA(0, 1, At, B1); PG8_BAR;
            PG8_LDA(At, 1, 1); PG8_STAGE(PG8_SA(1, 0), a3, voffA);
            PG8_BAR; PG8_WAIT_L(0); PG8_MMA(1, 0, At, B0); PG8_BAR; PG8_SCHED;
            PG8_STAGE(PG8_SB(1, 1), b3 + hstep, voffB);
            PG8_WAIT_V(6); PG8_BAR; PG8_MMA(1, 1, At, B1); PG8_BAR;
            }
        }
        if constexpr (ALIGN_EPI) { if (wr == 0) PG8_BAR; }
        if constexpr (!Epi::AFTER_DRAIN) { E(acc, cur, wr, wc, fr, fq); S.done(cur); }
        if (!has_next) break;
#pragma unroll
        for (int a = 0; a < 2; ++a)
#pragma unroll
            for (int b = 0; b < 2; ++b)
#pragma unroll
                for (int m = 0; m < 4; ++m)
#pragma unroll
                    for (int n = 0; n < 2; ++n) acc[a][b][m][n] = (f32x4){0.f, 0.f, 0.f, 0.f};
        cur = nxt; cA = nA; cB = nB; ++ui;
        if constexpr (ALIGN_EPI) { if (wr == 1) PG8_BAR; }
    }
    PG8_WAIT_V(0);
    if constexpr (!ALIGN_EPI) { if (wr == 0) PG8_BAR; }
    PG8_BAR;
    if constexpr (Epi::AFTER_DRAIN) { E.fused(acc, cur, wr, wc, fr, fq, lds, wid, lane); S.done(cur); }
#undef PG8_SA
#undef PG8_SB
#undef PG8_STAGE
#undef PG8_LDA
#undef PG8_LDB
#undef PG8_MMA
#undef PG8_WAIT_V
#undef PG8_WAIT_L
#undef PG8_BAR
#undef PG8_SCHED
}
}
using pg8::bf16_t; using pg8::bf16x8; using pg8::f32x4; using pg8::u32x4;
typedef unsigned u32x2 __attribute__((ext_vector_type(2)));
#define LAS __attribute__((address_space(3)))
constexpr int NB = 8, SEQ = 4096, T = NB * SEQ, D = 1024, FF = 2816, PT = 2604, PLD = 2816, NGU = 2 * FF;
constexpr int PC_A = 0, PC_B = 256, PC_Q = 1184, PC_KC = 1440, PC_VC = 1504, PC_KS = 1568, PC_VS = 1632, PC_KW = 1696, PC_VW = 1760, PC_U = 1824, PC_BB = 2080, PC_CC = 2336, PC_G = 2592;
constexpr size_t MiB = 1u << 20;
constexpr size_t WS_CTL = 0;
constexpr size_t WS_W0 = 1 * MiB, WS_LSTRIDE = 42 * MiB;
constexpr size_t WO_F1 = 0, WO_D1 = 11 * MiB, WO_F2 = 33 * MiB / 2, WO_D2 = 55 * MiB / 2, WO_IN = 33 * MiB, WO_OUT = 77 * MiB / 2, WO_CK = 81 * MiB / 2, WO_CV = 41 * MiB;
constexpr size_t WS_CBP = 85 * MiB;
constexpr size_t WS_SSQ = 86 * MiB;
constexpr size_t WS_P = 96 * MiB, WS_H = 96 * MiB, WS_YR = 96 * MiB;
constexpr size_t WS_XB = 272 * MiB;
constexpr size_t WS_R = 272 * MiB, WS_K = 288 * MiB, WS_V = 304 * MiB, WS_KK = 320 * MiB, WS_AKK = 336 * MiB, WS_GG = 352 * MiB, WS_DEC = 368 * MiB;
constexpr size_t WS_QN = 400 * MiB, WS_KSEL = 416 * MiB, WS_VSEL = 420 * MiB, WS_KWIN = 424 * MiB, WS_VWIN = 428 * MiB, WS_GATES = 432 * MiB, WS_KCMP = 434 * MiB, WS_VCMP = 434 * MiB + 512 * 1024;
constexpr size_t WS_Y = 440 * MiB, WS_END = 504 * MiB;
constexpr int LDS_BYTES = 147456;
constexpr int NPH = 19;

struct Args { const float* in[33]; float* out; unsigned char* ws; int lo, hi; };
constexpr size_t WS_IMG = 131072, IMG_LSTRIDE = 176128, IMG_RW = 0, IMG_POOL = 94208, IMG_W2 = 131072;
constexpr size_t WS_TAB = 65536;
#define INTAB(a) ((const float* const*)((a).ws + WS_TAB))

__device__ __forceinline__ float bf_lo(unsigned u) { return __uint_as_float(u << 16); }
__device__ __forceinline__ float bf_hi(unsigned u) { return __uint_as_float(u & 0xffff0000u); }
__device__ __forceinline__ float bf2f(bf16_t h) { return __uint_as_float((unsigned)h << 16); }
__device__ __forceinline__ unsigned f2bf(float f) { unsigned u = __float_as_uint(f); return (u + 0x7fffu + ((u >> 16) & 1u)) >> 16; }
__device__ __forceinline__ unsigned pk2(float lo, float hi) { return pg8::cvt_pk_bf16(lo, hi); }
__device__ __forceinline__ float sigmoidf_(float x) { return __builtin_amdgcn_rcpf(1.0f + __expf(-x)); }
#define LDS_WAIT() asm volatile("s_waitcnt lgkmcnt(0)" ::: "memory")
__device__ __forceinline__ f32x4 mma16(const LAS bf16_t* A, int lda, const LAS bf16_t* Bt, int ldb, int K, int lane, f32x4 acc) {
    const LAS bf16_t* ap = A + (lane & 15) * lda + (lane >> 4) * 8;
    const LAS bf16_t* bp = Bt + (lane & 15) * ldb + (lane >> 4) * 8;
    for (int k0 = 0; k0 < K; k0 += 32) {
        const bf16x8 av = *(const LAS bf16x8*)(ap + k0), bv = *(const LAS bf16x8*)(bp + k0);
        acc = __builtin_amdgcn_mfma_f32_16x16x32_bf16(bv, av, acc, 0, 0, 0);
    }
    return acc;
}
__device__ __forceinline__ float red8(float v) { v += __shfl_xor(v, 1); v += __shfl_xor(v, 2); v += __shfl_xor(v, 4); return v; }
__device__ __forceinline__ float red16(float v) { v += __shfl_xor(v, 1); v += __shfl_xor(v, 2); v += __shfl_xor(v, 4); v += __shfl_xor(v, 8); return v; }
template <int CTRL> __device__ __forceinline__ float dpp_add(float x) {
    return x + __builtin_bit_cast(float, __builtin_amdgcn_update_dpp(0, __builtin_bit_cast(int, x), CTRL, 0xf, 0xf, true));
}
template <int CTRL> __device__ __forceinline__ float dpp_get(float x) { return __builtin_bit_cast(float, __builtin_amdgcn_update_dpp(0, __builtin_bit_cast(int, x), CTRL, 0xf, 0xf, true)); }
__device__ __forceinline__ float allred16_dpp(float x) { x = dpp_add<0x128>(x); x = dpp_add<0x124>(x); x = dpp_add<0x122>(x); x = dpp_add<0x121>(x); return x; }

constexpr size_t WS_BAR = 32768;
#define XB_TMO      128
#define XB_XCNT(j)  (256  + 64 * (j))
#define XB_XSUB(j)  (1280 + 64 * (j))
#define XB_XGEN(j)  (2304 + 64 * (j))
#define XB_TOP      3328
#define XB_TOPGEN   3392
#define XCD_BAR_WORDS 3456
#define XB_SPIN_CAP (1u << 18)

__device__ __forceinline__ unsigned xb_ld(unsigned* p)              { return __hip_atomic_load(p, __ATOMIC_RELAXED, __HIP_MEMORY_SCOPE_AGENT); }
__device__ __forceinline__ unsigned xb_add(unsigned* p, unsigned v) { return __hip_atomic_fetch_add(p, v, __ATOMIC_RELAXED, __HIP_MEMORY_SCOPE_AGENT); }
__device__ __forceinline__ unsigned xb_xcc_id() { return (unsigned)__builtin_amdgcn_s_getreg((3 << 11) | 20) & 0xFu; }
#define XB_SPIN(cond, bar) do { unsigned _sp = 0; while (cond) { __builtin_amdgcn_s_sleep(1); \
    if ((++_sp & 255u) == 0u) { if (xb_ld(&(bar)[XB_TMO])) break; if (_sp > XB_SPIN_CAP) { atomicAdd(&(bar)[XB_TMO], 1u); break; } } } } while (0)

struct XcdBarrier {
    unsigned* bar; unsigned x;
    volatile LAS unsigned* st;
};

__device__ __forceinline__ XcdBarrier xcd_barrier_post(unsigned* bar, volatile LAS unsigned* st) {
    XcdBarrier b; b.bar = bar; b.x = xb_xcc_id(); b.st = st;
    if (threadIdx.x == 0) (void)xb_add(&bar[XB_XCNT(b.x)], 1u);
    return b;
}
__device__ __forceinline__ void xcd_barrier_complete(unsigned* bar, unsigned x, unsigned& nloc, unsigned& nx) {
    const unsigned G = gridDim.x * gridDim.y * gridDim.z;
    unsigned sum, cnt, mine, sp = 0u;
    for (;;) {
        sum = 0u; cnt = 0u; mine = 0u;
#pragma unroll
        for (unsigned j = 0; j < 16; ++j) { const unsigned c = xb_ld(&bar[XB_XCNT(j)]); sum += c; cnt += (c > 0u) ? 1u : 0u; mine = (j == x) ? c : mine; }
        if (sum == G) break;
        __builtin_amdgcn_s_sleep(1);
        if ((++sp & 255u) == 0u) { if (xb_ld(&bar[XB_TMO])) break; if (sp > XB_SPIN_CAP) { atomicAdd(&bar[XB_TMO], 1u); break; } }
    }
    nloc = mine > 0u ? mine : 1u; nx = cnt > 0u ? cnt : 1u;
}

__device__ __forceinline__ void xcd_barrier(const XcdBarrier& b) {
    asm volatile("s_waitcnt vmcnt(0)" ::: "memory");
    __syncthreads();
    if (threadIdx.x == 0) {
        unsigned* bar = b.bar;
        __builtin_amdgcn_s_waitcnt(0);
        unsigned nloc = b.st[0], nx = b.st[1];
        if (nloc == 0u) { xcd_barrier_complete(bar, b.x, nloc, nx); b.st[0] = nloc; b.st[1] = nx; }
        const unsigned old = xb_add(&bar[XB_XSUB(b.x)], 1u);
        const unsigned gen = old / nloc;
        if (old + 1u == (gen + 1u) * nloc) {
            __builtin_amdgcn_fence(__ATOMIC_RELEASE, "agent");
            asm volatile("s_waitcnt vmcnt(0)" ::: "memory");
            const unsigned og = xb_add(&bar[XB_TOP], 1u);
            const unsigned tg = og / nx;
            if (og + 1u == (tg + 1u) * nx) xb_add(&bar[XB_TOPGEN], 1u);
            else XB_SPIN(xb_ld(&bar[XB_TOPGEN]) == tg, bar);
            __builtin_amdgcn_fence(__ATOMIC_ACQUIRE, "agent");
            xb_add(&bar[XB_XGEN(b.x)], 1u);
            asm volatile("s_waitcnt vmcnt(0)" ::: "memory");
        } else {
            XB_SPIN(xb_ld(&bar[XB_XGEN(b.x)]) == gen, bar);
            __builtin_amdgcn_fence(__ATOMIC_ACQUIRE, "agent");
            asm volatile("s_waitcnt vmcnt(0)" ::: "memory");
        }
    }
    __syncthreads();
}

__device__ __forceinline__ int rowmap(int kind, int n) {
    if (kind == 0) return 256 * (n >> 7) + (n & 127);
    if (kind == 1) return 256 * (n >> 7) + 128 + (n & 127);
    if (kind == 3) return n < 1824 ? n : (n < 1836 ? PC_G + (n - 1824) : n - 12);
    return n;
}
struct TrDesc { const float* W; const float* gain; bf16_t* WT; int K, N, kind, k0, n0; };
__device__ __forceinline__ void tr_desc(const Args& a, int it, TrDesc& d) {
    constexpr int I_GU = 16 * 88, I_DN = 44 * 32, I_IN = 16 * 82, I_OUT = 16 * 32, I_C = 32 * 4;
    constexpr int I_LAYER = 4 * I_GU + 2 * I_DN + I_IN + I_OUT + 2 * I_C;
    const int l = it / I_LAYER; int r = it - l * I_LAYER;
    unsigned char* wb = a.ws + WS_W0 + (size_t)l * WS_LSTRIDE;
    const float* W; const float* gain = nullptr; bf16_t* WT; int K, N, kind;
    if (r < I_GU) { W = a.in[2] + (size_t)l * D * FF; K = D; N = FF; WT = (bf16_t*)(wb + WO_F1); kind = 0; gain = a.in[1] + l * D; }
    else if ((r -= I_GU) < I_GU) { W = a.in[3] + (size_t)l * D * FF; K = D; N = FF; WT = (bf16_t*)(wb + WO_F1); kind = 1; gain = a.in[1] + l * D; }
    else if ((r -= I_GU) < I_DN) { W = a.in[4] + (size_t)l * D * FF; K = FF; N = D; WT = (bf16_t*)(wb + WO_D1); kind = 2; }
    else if ((r -= I_DN) < I_GU) { W = a.in[30] + (size_t)l * D * FF; K = D; N = FF; WT = (bf16_t*)(wb + WO_F2); kind = 0; gain = a.in[29] + l * D; }
    else if ((r -= I_GU) < I_GU) { W = a.in[31] + (size_t)l * D * FF; K = D; N = FF; WT = (bf16_t*)(wb + WO_F2); kind = 1; gain = a.in[29] + l * D; }
    else if ((r -= I_GU) < I_DN) { W = a.in[32] + (size_t)l * D * FF; K = FF; N = D; WT = (bf16_t*)(wb + WO_D2); kind = 2; }
    else if ((r -= I_DN) < I_IN) { W = a.in[6] + (size_t)l * D * PT; K = D; N = PT; WT = (bf16_t*)(wb + WO_IN); kind = 3; gain = a.in[5] + l * D; }
    else if ((r -= I_IN) < I_OUT) { W = a.in[28] + (size_t)l * D * D; K = D; N = D; WT = (bf16_t*)(wb + WO_OUT); kind = 2; }
    else if ((r -= I_OUT) < I_C) { W = a.in[23] + (size_t)l * 2048 * 128; K = 2048; N = 128; WT = (bf16_t*)(wb + WO_CK); kind = 2; }
    else { r -= I_C; W = a.in[25] + (size_t)l * 2048 * 128; K = 2048; N = 128; WT = (bf16_t*)(wb + WO_CV); kind = 2; }
    const int nblk = (N + 31) >> 5, kb = r / nblk, nb = r - kb * nblk;
    d.W = W; d.gain = gain; d.WT = WT; d.K = K; d.N = N; d.kind = kind; d.k0 = 64 * kb; d.n0 = 32 * nb;
}
__device__ __forceinline__ void tr_load(const TrDesc& d, int lane, f32x4 (&v)[8]) {
    const int q4 = lane & 7, kr = lane >> 3, nn = d.n0 + 4 * q4, nc = nn < d.N ? nn : d.N - 4;
#pragma unroll
    for (int i = 0; i < 8; ++i) { const int kk = d.k0 + 8 * i + kr; f32x4 x = __builtin_nontemporal_load((const f32x4*)(d.W + (size_t)kk * d.N + nc));
        if (d.gain) x = x * d.gain[kk];
        if (nn >= d.N) x = (f32x4){0.f, 0.f, 0.f, 0.f};
        v[i] = x; }
}
__device__ __forceinline__ void tr_store(const TrDesc& d, int lane, const f32x4 (&v)[8], LAS float* scr) {
    { const int q4 = lane & 7, kr = lane >> 3;
#pragma unroll
      for (int i = 0; i < 8; ++i) { LAS float* p = scr + (8 * i + kr) * 33 + 4 * q4; p[0] = v[i][0]; p[1] = v[i][1]; p[2] = v[i][2]; p[3] = v[i][3]; } }
    LDS_WAIT();
    const int c = lane & 7;
#pragma unroll
    for (int j = 0; j < 4; ++j) { const int nl = (lane >> 3) + 8 * j, n = d.n0 + nl; const LAS float* s = scr + (8 * c) * 33 + nl;
        u32x4 o; o.x = pk2(s[0 * 33], s[1 * 33]); o.y = pk2(s[2 * 33], s[3 * 33]); o.z = pk2(s[4 * 33], s[5 * 33]); o.w = pk2(s[6 * 33], s[7 * 33]);
        if (n < d.N) *(u32x4*)(d.WT + (size_t)rowmap(d.kind, n) * d.K + d.k0 + 8 * c) = o; }
    LDS_WAIT();
}
__device__ __forceinline__ void prologue(const Args& a, LAS unsigned char* lds, int tid, int lane, int wave, int G, int bid, int rep) {
    LAS float* scr = (LAS float*)(lds + wave * 16384);
    const int gw = bid * 8 + wave, NGW = G * 8;
    if (bid == 0 && rep == 0 && tid < 64) ((unsigned*)(a.ws + WS_CTL))[tid * 64] = 0u;
    if (bid == 0 && tid < 33) ((const float**)(a.ws + WS_TAB))[tid] = a.in[tid];
    {
        constexpr int I_TOTAL = 2 * (4 * 16 * 88 + 2 * 44 * 32 + 16 * 82 + 16 * 32 + 2 * 32 * 4);
        TrDesc dc{}, dn{}; f32x4 vc[8] = {}, vn[8] = {};
        int it = gw;
        if (it < I_TOTAL) { tr_desc(a, it, dc); tr_load(dc, lane, vc); }
        while (it < I_TOTAL) {
            const int itn = it + NGW;
            if (itn < I_TOTAL) { tr_desc(a, itn, dn); tr_load(dn, lane, vn); }
            tr_store(dc, lane, vc, scr);
            dc = dn;
#pragma unroll
            for (int i = 0; i < 8; ++i) vc[i] = vn[i];
            it = itn;
        }
    }
    {
        const float* x = a.in[0]; bf16_t* XB = (bf16_t*)(a.ws + WS_XB); float* ssq = (float*)(a.ws + WS_SSQ);
#pragma unroll 4
        for (int m = gw; m < T; m += NGW) {
            const f32x4* xr = (const f32x4*)(x + (size_t)m * D) + lane; u32x2* brow = (u32x2*)(XB + (size_t)m * D) + lane;
#pragma unroll
            for (int j = 0; j < 4; ++j) { const f32x4 v = __builtin_nontemporal_load(xr + 64 * j); u32x2 w; w.x = pk2(v[0], v[1]); w.y = pk2(v[2], v[3]); brow[64 * j] = w;
                float ss = (v[0] * v[0] + v[1] * v[1]) + (v[2] * v[2] + v[3] * v[3]); ss = red16(ss);
                if ((lane & 15) == 0) ssq[(size_t)m * 16 + 4 * j + (lane >> 4)] = ss; }
        }
    }
    for (int e = bid * 512 + tid; e < 2 * 73728; e += G * 512) {
        const int l = e / 73728; int r = e - l * 73728; bf16_t* img = (bf16_t*)(a.ws + WS_IMG + (size_t)l * IMG_LSTRIDE);
        if (r < 16384) { const int k = r >> 8, n = r & 255, np = ((n & ~63) + 16 * (2 * ((n & 63) >> 5) + ((n >> 2) & 1)) + 4 * ((n >> 3) & 3) + (n & 3)); img[IMG_RW / 2 + np * 72 + k] = (bf16_t)f2bf(a.in[11][l * 16384 + r]); continue; } r -= 16384;
        if (r < 8192) { const int k = r >> 8, n = r & 255, np = ((n & ~63) + 16 * (2 * ((n & 63) >> 5) + ((n >> 2) & 1)) + 4 * ((n >> 3) & 3) + (n & 3)); img[IMG_RW / 2 + 18432 + np * 40 + k] = (bf16_t)f2bf(a.in[13][l * 8192 + r]); continue; } r -= 8192;
        if (r < 16384) { const int k = r >> 8, n = r & 255, np = ((n & ~63) + 16 * (2 * ((n & 63) >> 5) + ((n >> 2) & 1)) + 4 * ((n >> 3) & 3) + (n & 3)); img[IMG_RW / 2 + 28672 + np * 72 + k] = (bf16_t)f2bf(a.in[14][l * 16384 + r]); continue; } r -= 16384;
        if (r < 16384) { const int g = r >> 12, c = (r >> 6) & 63, d = r & 63; img[IMG_POOL / 2 + (g * 64 + d) * 72 + c] = (bf16_t)f2bf(a.in[7][l * 16384 + r]); continue; } r -= 16384;
        { const int kv = r >> 13, j = (r >> 6) & 127, d = r & 63; img[IMG_W2 / 2 + (kv * 64 + d) * 136 + j] = (bf16_t)f2bf((kv ? a.in[26] : a.in[24])[l * 8192 + (r & 8191)]); }
    }
    __syncthreads();
    for (int task = bid; task < 256; task += G) {
        const int l = task >> 7, kv = (task >> 6) & 1, part = task & 63;
        const float* pos = a.in[22] + l * 2048; const float* w1 = (kv ? a.in[25] : a.in[23]) + (size_t)l * 2048 * 128;
        const int j = tid & 127, sub = tid >> 7; float s = 0.f;
#pragma unroll
        for (int i = 0; i < 8; ++i) { const int ii = part * 32 + sub * 8 + i; s += pos[ii] * w1[(size_t)ii * 128 + j]; }
        LAS float* red = (LAS float*)lds;
        __syncthreads(); red[tid] = s; __syncthreads();
        if (tid < 128) ((float*)(a.ws + WS_CBP))[((l * 2 + kv) * 64 + part) * 128 + tid] = (red[tid] + red[tid + 128]) + (red[tid + 256] + red[tid + 384]);
    }
    __syncthreads();
}
__device__ __forceinline__ void pool_phase(const Args& a, int l, LAS unsigned char* lds, int tid, int lane, int wave, int G, int bid) {
    const bf16_t* P = (const bf16_t*)(a.ws + WS_P); bf16_t* Y = (bf16_t*)(a.ws + WS_Y);
    LAS bf16_t* U = (LAS bf16_t*)lds;
    LAS bf16_t* Dm = (LAS bf16_t*)(lds + 40960);
    LAS bf16_t* Wt = (LAS bf16_t*)(lds + 40960 + 33792);
    const float* pw = INTAB(a)[7] + l * 16384; const float* psc = INTAB(a)[8] + l * 256;
    { const u32x4* img = (const u32x4*)(a.ws + WS_IMG + (size_t)l * IMG_LSTRIDE + IMG_POOL); u32x4 r[5];
#pragma unroll
      for (int i = 0; i < 5; ++i) { const int q = tid + 512 * i; r[i] = img[q < 2304 ? q : 2303]; }
#pragma unroll
      for (int i = 0; i < 5; ++i) { const int q = tid + 512 * i; if (q < 2304) *(LAS u32x4*)((LAS unsigned char*)Wt + q * 16) = r[i]; } }
    for (int tile = bid; tile < T / 64; tile += G) {
        const int t0 = tile * 64, s0 = t0 & (SEQ - 1);
        __syncthreads();
        { u32x4 rr[5];
#pragma unroll
          for (int i = 0; i < 5; ++i) { const int pc = tid + 512 * i, r = pc >> 5, c8 = pc & 31, s = s0 - 16 + r; const int rowc = s >= 0 ? t0 - 16 + r : t0;
              rr[i] = *(const u32x4*)(P + (size_t)rowc * PLD + PC_A + c8 * 8); if (s < 0) rr[i] = (u32x4){0u, 0u, 0u, 0u}; }
#pragma unroll
          for (int i = 0; i < 5; ++i) { const int pc = tid + 512 * i, r = pc >> 5, c8 = pc & 31; *(LAS u32x4*)(U + r * 256 + c8 * 8) = rr[i]; } }
        __syncthreads();
        { const int c = tid & 255, half = tid >> 8, wlen = 2 << (c >> 6), tk0 = half * 32;
          float sum = 0.f;
          for (int jj = 1; jj < wlen; ++jj) sum += bf2f(U[(tk0 + 16 - jj) * 256 + c]);
#pragma unroll 8
          for (int tk = tk0; tk < tk0 + 32; ++tk) { const int r = tk + 16, s = s0 + tk, cnt = (s + 1 < wlen) ? s + 1 : wlen;
              const float cur = bf2f(U[r * 256 + c]), old = bf2f(U[(r - wlen + 1) * 256 + c]); sum += cur;
              Dm[tk * 264 + c] = (bf16_t)f2bf(sum * __builtin_amdgcn_rcpf((float)cnt) - cur); sum -= old; } }
        __syncthreads();
#pragma unroll
        for (int x = 0; x < 2; ++x) { const int nt = 2 * wave + x, g = nt >> 2;
            for (int mt = 0; mt < 4; ++mt) {
                f32x4 acc = mma16(Dm + 16 * mt * 264 + g * 64, 264, Wt + (g * 64 + (nt & 3) * 16) * 72, 72, 64, lane, (f32x4){0.f, 0.f, 0.f, 0.f});
                const int tok = 16 * mt + (lane & 15), col = 16 * nt + 4 * (lane >> 4); const f32x4 sc = *(const f32x4*)(psc + col);
                u32x2 w; w.x = pk2(acc[0] * sc[0], acc[1] * sc[1]); w.y = pk2(acc[2] * sc[2], acc[3] * sc[3]);
                *(u32x2*)(Y + (size_t)(t0 + tok) * D + col) = w; } }
    }
    __syncthreads();
}
__device__ __forceinline__ void unpack8(const u32x4 v, float (&f)[8]) {
    f[0] = bf_lo(v.x); f[1] = bf_hi(v.x); f[2] = bf_lo(v.y); f[3] = bf_hi(v.y); f[4] = bf_lo(v.z); f[5] = bf_hi(v.z); f[6] = bf_lo(v.w); f[7] = bf_hi(v.w);
}
__device__ __forceinline__ void conv_phase(const Args& a, int l, int tid, int G, int bid) {
    const bf16_t* __restrict__ P = (const bf16_t*)(a.ws + WS_P); bf16_t* __restrict__ Y = (bf16_t*)(a.ws + WS_Y);
    const float* __restrict__ cw = INTAB(a)[27] + l * 768;
    const int ch = (tid & 31) * 8;
    float w0[8], w1[8], w2[8];
#pragma unroll
    for (int e = 0; e < 8; ++e) { w0[e] = cw[ch + e]; w1[e] = cw[256 + ch + e]; w2[e] = cw[512 + ch + e]; }
#pragma unroll 4
    for (int t = bid * 16 + (tid >> 5); t < T; t += G * 16) {
        const int s = t & (SEQ - 1);
        const bf16_t* pr = P + (size_t)t * PLD;
        const u32x4 z4 = (u32x4){0u, 0u, 0u, 0u};
        const u32x4 u0 = *(const u32x4*)(pr + PC_U + ch), c0 = *(const u32x4*)(pr + PC_CC + ch), b0 = *(const u32x4*)(pr + PC_BB + ch);
        const bf16_t* pr1 = s >= 1 ? pr - PLD : pr; const bf16_t* pr2 = s >= 2 ? pr - 2 * PLD : pr;
        u32x4 u1 = *(const u32x4*)(pr1 + PC_U + ch), c1 = *(const u32x4*)(pr1 + PC_CC + ch), u2 = *(const u32x4*)(pr2 + PC_U + ch), c2 = *(const u32x4*)(pr2 + PC_CC + ch);
        if (s < 1) { u1 = z4; c1 = z4; } if (s < 2) { u2 = z4; c2 = z4; }
        float fu0[8], fc0[8], fb0[8], fu1[8], fc1[8], fu2[8], fc2[8], o[8];
        unpack8(u0, fu0); unpack8(c0, fc0); unpack8(b0, fb0); unpack8(u1, fu1); unpack8(c1, fc1); unpack8(u2, fu2); unpack8(c2, fc2);
#pragma unroll
        for (int e = 0; e < 8; ++e) o[e] = fb0[e] * (w0[e] * (fc2[e] * fu2[e]) + w1[e] * (fc1[e] * fu1[e]) + w2[e] * (fc0[e] * fu0[e]));
        u32x4 w; w.x = pk2(o[0], o[1]); w.y = pk2(o[2], o[3]); w.z = pk2(o[4], o[5]); w.w = pk2(o[6], o[7]);
        *(u32x4*)(Y + (size_t)t * D + 768 + ch) = w;
    }
}
__device__ __forceinline__ void rwkv_prep_phase(const Args& a, int l, LAS unsigned char* lds, int tid, int lane, int wave, int G, int bid) {
    const bf16_t* __restrict__ P = (const bf16_t*)(a.ws + WS_P);
    LAS bf16_t* WU = (LAS bf16_t*)lds;
    LAS bf16_t* AU = (LAS bf16_t*)(lds + 36864);
    LAS bf16_t* GU = (LAS bf16_t*)(lds + 57344);
    LAS bf16_t* Tw = (LAS bf16_t*)(lds + 94208);
    LAS bf16_t* Ta = (LAS bf16_t*)(lds + 103424);
    LAS bf16_t* Tg = (LAS bf16_t*)(lds + 108544);
    LAS float* WT7 = (LAS float*)(lds + 117760);
    const float* mu = INTAB(a)[9] + l * 928; const float* w0 = INTAB(a)[10] + l * 256; const float* wup = INTAB(a)[11] + l * 64 * 256; const float* a0 = INTAB(a)[12] + l * 256;
    const float* aup = INTAB(a)[13] + l * 32 * 256; const float* gup = INTAB(a)[14] + l * 64 * 256; const float* kkw = INTAB(a)[15] + l * 256; const float* kaw = INTAB(a)[16] + l * 256;
    bf16_t* __restrict__ Ro = (bf16_t*)(a.ws + WS_R); bf16_t* __restrict__ Ko = (bf16_t*)(a.ws + WS_K); bf16_t* __restrict__ Vo = (bf16_t*)(a.ws + WS_V); bf16_t* __restrict__ KKo = (bf16_t*)(a.ws + WS_KK);
    bf16_t* __restrict__ AKKo = (bf16_t*)(a.ws + WS_AKK); bf16_t* __restrict__ Go = (bf16_t*)(a.ws + WS_GG); float* __restrict__ DECo = (float*)(a.ws + WS_DEC);
    { const u32x4* img = (const u32x4*)(a.ws + WS_IMG + (size_t)l * IMG_LSTRIDE + IMG_RW); u32x4 r[12];
#pragma unroll
      for (int i = 0; i < 12; ++i) { const int q = tid + 512 * i; r[i] = img[q < 5888 ? q : 5887]; }
#pragma unroll
      for (int i = 0; i < 12; ++i) { const int q = tid + 512 * i; if (q < 5888) *(LAS u32x4*)(lds + q * 16) = r[i]; } }
    for (int e = tid; e < 7 * 256; e += 512) { const int v = e >> 8, c = e & 255; WT7[e] = v == 0 ? mu[c] : v == 1 ? mu[256 + c] : v == 2 ? mu[512 + c] : v == 3 ? w0[c] : v == 4 ? a0[c] : v == 5 ? kkw[c] : kaw[c]; }
    for (int tile = bid; tile < T / 64; tile += G) {
        const int t0 = tile * 64, s0 = t0 & (SEQ - 1);
        __syncthreads();
        { u32x4 cu[3], pv[3];
#pragma unroll
          for (int i = 0; i < 3; ++i) { int gi = tid + 512 * i; gi = gi < 1280 ? gi : 1279; const int tok = gi / 20, g8 = gi - tok * 20; const size_t t = (size_t)(t0 + tok);
              const bf16_t* pc = P + t * PLD + PC_B + 768 + g8 * 8; cu[i] = *(const u32x4*)pc; pv[i] = *(const u32x4*)((s0 + tok > 0) ? pc - PLD : pc); }
#pragma unroll
          for (int i = 0; i < 3; ++i) { const int gi = tid + 512 * i; if (gi < 1280) { const int tok = gi / 20, g8 = gi - tok * 20, j0 = g8 * 8; const bool hp = (s0 + tok) > 0;
              float fc[8], fp[8], ov[8]; unpack8(cu[i], fc); unpack8(pv[i], fp);
              const f32x4 m0 = *(const f32x4*)(mu + 768 + j0), m1 = *(const f32x4*)(mu + 768 + j0 + 4);
#pragma unroll
              for (int e = 0; e < 8; ++e) { const float pvv = hp ? fp[e] : 0.f; const float val = fc[e] + (e < 4 ? m0[e & 3] : m1[e & 3]) * (pvv - fc[e]);
                  const float sg = sigmoidf_(j0 < 64 ? 2.0f * val : val); ov[e] = j0 < 64 ? 2.0f * sg - 1.0f : (j0 < 96 ? val : sg); }
              u32x4 w; w.x = pk2(ov[0], ov[1]); w.y = pk2(ov[2], ov[3]); w.z = pk2(ov[4], ov[5]); w.w = pk2(ov[6], ov[7]);
              LAS bf16_t* dst = j0 < 64 ? Tw + tok * 72 + j0 : (j0 < 96 ? Ta + tok * 40 + (j0 - 64) : Tg + tok * 72 + (j0 - 96));
              *(LAS u32x4*)dst = w; } } }
        __syncthreads();
#pragma unroll 1
        for (int x = 0; x < 2; ++x) { const int task = wave * 2 + x, mt = task >> 2, h = task & 3;
            const int tok = 16 * mt + (lane & 15), t = t0 + tok, fq = lane >> 4; const bool hasprev = (s0 + tok) > 0;
            float kkr[2][8], av[2][8]; float ss = 0.f;
            u32x4 prc[2][3], prp_[2][3];
            { const bf16_t* pr0 = P + (size_t)t * PLD + PC_B + h * 64 + 8 * fq; const bf16_t* pp0 = hasprev ? pr0 - PLD : pr0;
#pragma unroll
              for (int pp = 0; pp < 2; ++pp)
#pragma unroll
                  for (int q = 0; q < 3; ++q) { prc[pp][q] = *(const u32x4*)(pr0 + pp * 32 + q * 256); prp_[pp][q] = *(const u32x4*)(pp0 + pp * 32 + q * 256); } }
#pragma unroll
            for (int pp = 0; pp < 2; ++pp) { const int n0 = h * 64 + pp * 32, col = n0 + 8 * fq; const f32x4 z = (f32x4){0.f, 0.f, 0.f, 0.f};
                const f32x4 aw0 = mma16(Tw + 16 * mt * 72, 72, WU + n0 * 72, 72, 64, lane, z), aw1 = mma16(Tw + 16 * mt * 72, 72, WU + (n0 + 16) * 72, 72, 64, lane, z);
                const f32x4 aa0 = mma16(Ta + 16 * mt * 40, 40, AU + n0 * 40, 40, 32, lane, z), aa1 = mma16(Ta + 16 * mt * 40, 40, AU + (n0 + 16) * 40, 40, 32, lane, z);
                const f32x4 ag0 = mma16(Tg + 16 * mt * 72, 72, GU + n0 * 72, 72, 64, lane, z), ag1 = mma16(Tg + 16 * mt * 72, 72, GU + (n0 + 16) * 72, 72, 64, lane, z);
                float rc[8], kc[8], vc[8], rp[8], kp[8], vp[8];
                unpack8(prc[pp][0], rc); unpack8(prc[pp][1], kc); unpack8(prc[pp][2], vc); unpack8(prp_[pp][0], rp); unpack8(prp_[pp][1], kp); unpack8(prp_[pp][2], vp);
                float r8[8], k8[8], v8[8], g8[8], d8[8];
#pragma unroll
                for (int e = 0; e < 8; ++e) {
                    const int c = col + e;
                    const float rprev = hasprev ? rp[e] : 0.f, kprev = hasprev ? kp[e] : 0.f, vprev = hasprev ? vp[e] : 0.f;
                    r8[e] = rc[e] + WT7[c] * (rprev - rc[e]);
                    const float kraw = kc[e] + WT7[256 + c] * (kprev - kc[e]);
                    v8[e] = vc[e] + WT7[512 + c] * (vprev - vc[e]);
                    const float accw = e < 4 ? aw0[e & 3] : aw1[e & 3], acca = e < 4 ? aa0[e & 3] : aa1[e & 3], accg = e < 4 ? ag0[e & 3] : ag1[e & 3];
                    const float wv = WT7[768 + c] + accw; d8[e] = __expf(-0.6065306597126334f * sigmoidf_(wv));
                    const float aa = sigmoidf_(WT7[1024 + c] + acca); av[pp][e] = aa; g8[e] = accg;
                    const float kq = kraw * WT7[1280 + c]; kkr[pp][e] = kq; ss += kq * kq;
                    k8[e] = kraw * (1.0f + (aa - 1.0f) * WT7[1536 + c]);
                }
                const size_t o = (size_t)t * 256 + col;
                u32x4 w; w.x = pk2(r8[0], r8[1]); w.y = pk2(r8[2], r8[3]); w.z = pk2(r8[4], r8[5]); w.w = pk2(r8[6], r8[7]); *(u32x4*)(Ro + o) = w;
                w.x = pk2(k8[0], k8[1]); w.y = pk2(k8[2], k8[3]); w.z = pk2(k8[4], k8[5]); w.w = pk2(k8[6], k8[7]); *(u32x4*)(Ko + o) = w;
                w.x = pk2(v8[0], v8[1]); w.y = pk2(v8[2], v8[3]); w.z = pk2(v8[4], v8[5]); w.w = pk2(v8[6], v8[7]); *(u32x4*)(Vo + o) = w;
                w.x = pk2(g8[0], g8[1]); w.y = pk2(g8[2], g8[3]); w.z = pk2(g8[4], g8[5]); w.w = pk2(g8[6], g8[7]); *(u32x4*)(Go + o) = w;
                *(f32x4*)(DECo + o) = (f32x4){d8[0], d8[1], d8[2], d8[3]}; *(f32x4*)(DECo + o + 4) = (f32x4){d8[4], d8[5], d8[6], d8[7]};
            }
            ss += __shfl_xor(ss, 16); ss += __shfl_xor(ss, 32);
            const float inv = rsqrtf(fmaxf(ss, 1e-24f));
#pragma unroll
            for (int pp = 0; pp < 2; ++pp) { const size_t o = (size_t)t * 256 + h * 64 + pp * 32 + 8 * fq;
                float q[8], qa[8];
#pragma unroll
                for (int e = 0; e < 8; ++e) { q[e] = kkr[pp][e] * inv; qa[e] = q[e] * av[pp][e]; }
                u32x4 w; w.x = pk2(q[0], q[1]); w.y = pk2(q[2], q[3]); w.z = pk2(q[4], q[5]); w.w = pk2(q[6], q[7]); *(u32x4*)(KKo + o) = w;
                w.x = pk2(qa[0], qa[1]); w.y = pk2(qa[2], qa[3]); w.z = pk2(qa[4], qa[5]); w.w = pk2(qa[6], qa[7]); *(u32x4*)(AKKo + o) = w; }
        }
    }
    __syncthreads();
}
__device__ __forceinline__ void nsa_prep_phase(const Args& a, int l, int tid, int G, int bid) {
    const bf16_t* __restrict__ P = (const bf16_t*)(a.ws + WS_P);
    const float* __restrict__ qw = INTAB(a)[20] + l * 64; const float* __restrict__ kw = INTAB(a)[21] + l * 192;
    bf16_t* __restrict__ QN = (bf16_t*)(a.ws + WS_QN); bf16_t* __restrict__ KSEL = (bf16_t*)(a.ws + WS_KSEL); bf16_t* __restrict__ VSEL = (bf16_t*)(a.ws + WS_VSEL); bf16_t* __restrict__ KWIN = (bf16_t*)(a.ws + WS_KWIN); bf16_t* __restrict__ VWIN = (bf16_t*)(a.ws + WS_VWIN);
    float* __restrict__ GATES = (float*)(a.ws + WS_GATES);
    const int sub = tid & 7, vi = (tid >> 3) & 7;
    const int scol = vi < 4 ? PC_Q + vi * 64 : (vi == 4 ? PC_KS : (vi == 5 ? PC_KW : (vi == 6 ? PC_VS : PC_VW)));
    const float* nwp = vi < 4 ? qw : (vi == 4 ? kw + 64 : kw + 128);
    const f32x4 nw0 = *(const f32x4*)(nwp + sub * 8), nw1 = *(const f32x4*)(nwp + sub * 8 + 4);
    bf16_t* dbase = vi < 4 ? QN + vi * 64 : (vi == 4 ? KSEL : (vi == 5 ? KWIN : (vi == 6 ? VSEL : VWIN)));
    const int dstride = vi < 4 ? 256 : 64;
    const float qsc = vi < 4 ? (0.125f * 1.4426950408889634f) : 1.0f;
#pragma unroll 4
    for (int t = bid * 8 + (tid >> 6); t < T; t += G * 8) {
        const u32x4 v = *(const u32x4*)(P + (size_t)t * PLD + scol + sub * 8);
        float f[8]; unpack8(v, f);
        float ss = ((f[0] * f[0] + f[1] * f[1]) + (f[2] * f[2] + f[3] * f[3])) + ((f[4] * f[4] + f[5] * f[5]) + (f[6] * f[6] + f[7] * f[7])); ss = red8(ss);
        const float sc = qsc * rsqrtf(ss * (1.0f / 64.0f) + 1e-6f);
        u32x4 w = v;
        if (vi < 6) { w.x = pk2(f[0] * sc * nw0[0], f[1] * sc * nw0[1]); w.y = pk2(f[2] * sc * nw0[2], f[3] * sc * nw0[3]); w.z = pk2(f[4] * sc * nw1[0], f[5] * sc * nw1[1]); w.w = pk2(f[6] * sc * nw1[2], f[7] * sc * nw1[3]); }
        *(u32x4*)(dbase + (size_t)t * dstride + sub * 8) = w;
    }
#pragma unroll 3
    for (int e = bid * 512 + tid; e < T * 12; e += G * 512) { const int t = e / 12, j = e - t * 12; GATES[e] = sigmoidf_(bf2f(P[(size_t)t * PLD + PC_G + j])); }
}
__device__ __forceinline__ float gelu_tanh(float x) { const float u = 0.7978845608028654f * (x + 0.044715f * x * x * x); return 0.5f * x * (1.0f + tanhf(u)); }
__device__ __forceinline__ void compress_phase(const Args& a, int l, LAS unsigned char* lds, int tid, int lane, int wave, int G, int bid) {
    const bf16_t* P = (const bf16_t*)(a.ws + WS_P);
    LAS bf16_t* KC = (LAS bf16_t*)lds;
    LAS bf16_t* VC = (LAS bf16_t*)(lds + 39168);
    LAS bf16_t* HK = (LAS bf16_t*)(lds + 78336);
    LAS bf16_t* W2 = (LAS bf16_t*)(lds + 87040);
    LAS float* OK = (LAS float*)(lds + 121856);
    LAS float* BI = (LAS float*)(lds + 125952);
    const bf16_t* WCK = (const bf16_t*)(a.ws + WS_W0 + (size_t)l * WS_LSTRIDE + WO_CK); const bf16_t* WCV = (const bf16_t*)(a.ws + WS_W0 + (size_t)l * WS_LSTRIDE + WO_CV);
    bf16_t* KCMP = (bf16_t*)(a.ws + WS_KCMP); bf16_t* VCMP = (bf16_t*)(a.ws + WS_VCMP);
    const float* knw = INTAB(a)[21] + l * 192;
    { const u32x4* img = (const u32x4*)(a.ws + WS_IMG + (size_t)l * IMG_LSTRIDE + IMG_W2); u32x4 r[5];
#pragma unroll
      for (int i = 0; i < 5; ++i) { const int q = tid + 512 * i; r[i] = img[q < 2176 ? q : 2175]; }
#pragma unroll
      for (int i = 0; i < 5; ++i) { const int q = tid + 512 * i; if (q < 2176) *(LAS u32x4*)((LAS unsigned char*)W2 + q * 16) = r[i]; } }
    if (tid < 256) { const int kv = tid >> 7, j = tid & 127; const float* cb = (const float*)(a.ws + WS_CBP) + ((l * 2 + kv) * 64) * 128 + j; float s = 0.f;
#pragma unroll 16
        for (int p = 0; p < 64; ++p) s += cb[p * 128]; BI[tid] = s; }
    for (int unit = bid; unit < 256; unit += G) {
        const int b = unit >> 5, grp = (unit >> 1) & 15, kv = unit & 1, sbase = 256 * grp;
        __syncthreads();
        { u32x4 rr[5];
#pragma unroll
          for (int i = 0; i < 5; ++i) { int pc = tid + 512 * i; pc = pc < 2176 ? pc : 2175; const int r = pc >> 3, c8 = pc & 7, sx = sbase + r; const int sc_ = sx < SEQ ? sx : SEQ - 1;
              rr[i] = *(const u32x4*)(P + (size_t)(b * SEQ + sc_) * PLD + (kv ? PC_VC : PC_KC) + c8 * 8); if (sx >= SEQ) rr[i] = (u32x4){0u, 0u, 0u, 0u}; }
#pragma unroll
          for (int i = 0; i < 5; ++i) { const int pc = tid + 512 * i; if (pc < 2176) { const int r = pc >> 3, c8 = pc & 7; *(LAS u32x4*)(KC + r * 72 + c8 * 8) = rr[i]; } } }
        __syncthreads();
        { const int nt = wave;
            const LAS bf16_t* ap = KC + 16 * (lane & 15) * 72 + 8 * (lane >> 4);
            const bf16_t* bp = (kv ? WCV : WCK) + (size_t)(nt * 16 + (lane & 15)) * 2048 + 8 * (lane >> 4);
            f32x4 acc = (f32x4){0.f, 0.f, 0.f, 0.f};
#pragma unroll 16
            for (int j = 0; j < 32; ++j) {
                const bf16x8 a0 = *(const LAS bf16x8*)(ap + j * 72), a1 = *(const LAS bf16x8*)(ap + j * 72 + 32);
                const bf16x8 b0 = *(const bf16x8*)(bp + j * 64), b1 = *(const bf16x8*)(bp + j * 64 + 32);
                acc = __builtin_amdgcn_mfma_f32_16x16x32_bf16(b0, a0, acc, 0, 0, 0);
                acc = __builtin_amdgcn_mfma_f32_16x16x32_bf16(b1, a1, acc, 0, 0, 0);
            }
            const int m = lane & 15, col = nt * 16 + 4 * (lane >> 4);
            float hv[4];
#pragma unroll
            for (int i = 0; i < 4; ++i) hv[i] = gelu_tanh(acc[i] + BI[kv * 128 + col + i]);
            u32x2 w; w.x = pk2(hv[0], hv[1]); w.y = pk2(hv[2], hv[3]);
            *(LAS u32x2*)(HK + m * 136 + col) = w;
        }
        __syncthreads();
        if (wave < 4) { const int nt2 = wave;
          const f32x4 acc = mma16(HK, 136, W2 + (kv * 64 + nt2 * 16) * 136, 136, 128, lane, (f32x4){0.f, 0.f, 0.f, 0.f});
          const int m = lane & 15, d0 = nt2 * 16 + 4 * (lane >> 4), n = 16 * grp + m;
          if (kv == 1) { u32x2 w; w.x = pk2(acc[0], acc[1]); w.y = pk2(acc[2], acc[3]); *(u32x2*)(VCMP + (size_t)(b * 256 + n) * 64 + d0) = w; }
          else *(LAS f32x4*)(OK + m * 64 + d0) = acc; }
        __syncthreads();
        if (kv == 0 && tid < 256) { const int m = tid >> 4, sub = tid & 15; const f32x4 v = *(const LAS f32x4*)(OK + m * 64 + sub * 4);
            float ss = (v[0] * v[0] + v[1] * v[1]) + (v[2] * v[2] + v[3] * v[3]); ss = red16(ss);
            const float rs = rsqrtf(ss * (1.0f / 64.0f) + 1e-6f); const float* nw = knw + sub * 4;
            u32x2 w; w.x = pk2(v[0] * rs * nw[0], v[1] * rs * nw[1]); w.y = pk2(v[2] * rs * nw[2], v[3] * rs * nw[3]);
            *(u32x2*)(KCMP + (size_t)(b * 256 + 16 * grp + m) * 64 + sub * 4) = w; }
    }
    __syncthreads();
}
constexpr int SC_CH = 32, SC_STEP = 336;
__device__ __forceinline__ void scan_phase(const Args& a, LAS unsigned char* lds, int tid, int lane, int wave, int G, int bid) {
    LAS float* OP = (LAS float*)lds;
    LAS float* VV = (LAS float*)(lds + 2 * SC_CH * SC_STEP * 4);
    LAS float* YB = VV + 2 * 512;
    const bf16_t* Rr = (const bf16_t*)(a.ws + WS_R); const bf16_t* Kr = (const bf16_t*)(a.ws + WS_K); const bf16_t* Vr = (const bf16_t*)(a.ws + WS_V);
    const bf16_t* KKr = (const bf16_t*)(a.ws + WS_KK); const bf16_t* AKKr = (const bf16_t*)(a.ws + WS_AKK); const float* DECr = (const float*)(a.ws + WS_DEC);
    float* YR = (float*)(a.ws + WS_YR);
    for (int unit = bid; unit < 128; unit += G) {
        const int b = unit >> 4, h = (unit >> 2) & 3, v0 = (unit & 3) * 16;
        const size_t tb = (size_t)b * SEQ;
        const int sid = tid & 255, pst = sid >> 3, pg8 = sid & 7, vst = (sid & 63) >> 1, vhalf = sid & 1;
        const size_t po = (tb + pst) * 256 + h * 64 + pg8 * 8;
        const float* srcD = DECr + (tb + (sid >> 4)) * 256 + h * 64 + (sid & 15) * 4;
        const bf16_t* srcV = Vr + (tb + vst) * 256 + h * 64 + v0 + vhalf * 8;
        const int ldP = pst * SC_STEP + pg8 * 8, ldD = (sid >> 4) * SC_STEP + 128 + (sid & 15) * 4;
        const u32x4 zz = (u32x4){0u, 0u, 0u, 0u};
        u32x4 rKK = zz, rAK = zz, rK = zz, rR = zz, rV = zz; f32x4 rD0 = (f32x4){0.f, 0.f, 0.f, 0.f}, rD1 = rD0;
        const bool stager = wave >= 4;
#define SCAN_ISSUE(CH) do { if (stager) { const size_t co = (size_t)(CH) * SC_CH * 256; rKK = *(const u32x4*)(KKr + po + co); rAK = *(const u32x4*)(AKKr + po + co); rK = *(const u32x4*)(Kr + po + co); rR = *(const u32x4*)(Rr + po + co); \
            rD0 = *(const f32x4*)(srcD + co); rD1 = *(const f32x4*)(srcD + co + 16 * 256); if (sid < 64) rV = *(const u32x4*)(srcV + co); } } while (0)
#define SCAN_PUT8(dst, v) do { *(LAS f32x4*)(dst) = (f32x4){bf_lo((v).x), bf_hi((v).x), bf_lo((v).y), bf_hi((v).y)}; *(LAS f32x4*)((dst) + 4) = (f32x4){bf_lo((v).z), bf_hi((v).z), bf_lo((v).w), bf_hi((v).w)}; } while (0)
        typedef float f32x2 __attribute__((ext_vector_type(2)));
        f32x2 Sa = (f32x2){0.f, 0.f}, Sb = (f32x2){0.f, 0.f};
        const int lr = lane >> 4, c = lane & 15, row = 4 * wave + lr;
        float wsel[16];
#pragma unroll
        for (int q = 0; q < 16; ++q) wsel[q] = (c == q) ? 1.0f : 0.0f;
        SCAN_ISSUE(0);
        __syncthreads();
        for (int ch = 0; ch < SEQ / SC_CH; ++ch) {
            LAS float* buf = OP + (ch & 1) * SC_CH * SC_STEP;
            if (stager) { SCAN_PUT8(buf + ldP, rKK); SCAN_PUT8(buf + ldP + 64, rAK); SCAN_PUT8(buf + ldP + 192, rK); SCAN_PUT8(buf + ldP + 256, rR);
                *(LAS f32x4*)(buf + ldD) = rD0; *(LAS f32x4*)(buf + ldD + 16 * SC_STEP) = rD1;
                if (sid < 64) { LAS float* vd = VV + (ch & 1) * 512 + (vst >> 2) * 64 + (vhalf * 8) * 4 + (vst & 3); vd[0] = bf_lo(rV.x); vd[4] = bf_hi(rV.x); vd[8] = bf_lo(rV.y); vd[12] = bf_hi(rV.y); vd[16] = bf_lo(rV.z); vd[20] = bf_hi(rV.z); vd[24] = bf_lo(rV.w); vd[28] = bf_hi(rV.w); } }
            __syncthreads();
            if (ch + 1 < SEQ / SC_CH) SCAN_ISSUE(ch + 1);
            if (wave < 4) {
                const LAS float* op0 = buf + 4 * c; const LAS float* vv0 = VV + (ch & 1) * 512 + row * 4;
                f32x4 nkk = *(const LAS f32x4*)(op0), nak = *(const LAS f32x4*)(op0 + 64), nw = *(const LAS f32x4*)(op0 + 128), nk = *(const LAS f32x4*)(op0 + 192), nr = *(const LAS f32x4*)(op0 + 256);
                f32x4 nv[4] = {*(const LAS f32x4*)(vv0), *(const LAS f32x4*)(vv0 + 64), *(const LAS f32x4*)(vv0 + 128), *(const LAS f32x4*)(vv0 + 192)};
#pragma unroll 1
                for (int oh = 0; oh < 2; ++oh) {
                    const LAS float* opb = op0 + oh * 16 * SC_STEP;
                    const f32x4 vq[4] = {nv[0], nv[1], nv[2], nv[3]};
                    { const int ohn = oh < 1 ? 1 : 1;
#pragma unroll
                      for (int q = 0; q < 4; ++q) nv[q] = *(const LAS f32x4*)(vv0 + (ohn * 4 + q) * 64); }
                    float yk = 0.f;
#pragma unroll
                    for (int i = 0; i < 16; ++i) {
                        const f32x4 kk4 = nkk, ak4 = nak, w4 = nw, k4 = nk, r4 = nr; const float vv = vq[i >> 2][i & 3];
                        { const int nx = (i < 15) ? (i + 1) : (oh < 1 ? 16 : 15); const LAS float* on = opb + nx * SC_STEP;
                          nkk = *(const LAS f32x4*)(on); nak = *(const LAS f32x4*)(on + 64); nw = *(const LAS f32x4*)(on + 128); nk = *(const LAS f32x4*)(on + 192); nr = *(const LAS f32x4*)(on + 256); }
                        f32x2 t = Sa * (f32x2){kk4[0], kk4[1]}; t = __builtin_elementwise_fma(Sb, (f32x2){kk4[2], kk4[3]}, t);
                        float sa = t.x + t.y;
                        sa = allred16_dpp(sa);
                        const f32x2 nsa2 = (f32x2){-sa, -sa}, vv2 = (f32x2){vv, vv};
                        f32x2 ua = vv2 * (f32x2){k4[0], k4[1]}, ub = vv2 * (f32x2){k4[2], k4[3]};
                        ua = __builtin_elementwise_fma(nsa2, (f32x2){ak4[0], ak4[1]}, ua); ub = __builtin_elementwise_fma(nsa2, (f32x2){ak4[2], ak4[3]}, ub);
                        Sa = __builtin_elementwise_fma(Sa, (f32x2){w4[0], w4[1]}, ua); Sb = __builtin_elementwise_fma(Sb, (f32x2){w4[2], w4[3]}, ub);
                        f32x2 yy = Sa * (f32x2){r4[0], r4[1]}; yy = __builtin_elementwise_fma(Sb, (f32x2){r4[2], r4[3]}, yy);
                        float y = yy.x + yy.y;
                        y = allred16_dpp(y);
                        yk = fmaf(wsel[i], y, yk);
                    }
                    YB[(oh * 16 + c) * 16 + row] = yk;
                }
            }
            __syncthreads();
            if (stager) { const int st = sid >> 3, r2 = (sid & 7) * 2; const f32x2 yv = *(const LAS f32x2*)(YB + st * 16 + r2); *(f32x2*)(YR + (tb + (size_t)ch * SC_CH + st) * 256 + h * 64 + v0 + r2) = yv; }
        }
        __syncthreads();
    }
}
__device__ __forceinline__ void rwkv_out_phase(const Args& a, int l, int tid, int G, int bid) {
    const float* __restrict__ YR = (const float*)(a.ws + WS_YR); bf16_t* __restrict__ Y = (bf16_t*)(a.ws + WS_Y);
    const bf16_t* __restrict__ Rr = (const bf16_t*)(a.ws + WS_R); const bf16_t* __restrict__ Kr = (const bf16_t*)(a.ws + WS_K); const bf16_t* __restrict__ Vr = (const bf16_t*)(a.ws + WS_V); const bf16_t* __restrict__ Gr = (const bf16_t*)(a.ws + WS_GG);
    const float* rk = INTAB(a)[17] + l * 256; const float* lw = INTAB(a)[18] + l * 256; const float* lb = INTAB(a)[19] + l * 256;
    const int sub = tid & 7, c0 = ((tid >> 3) & 3) * 64 + sub * 8;
    const f32x4 rk0 = *(const f32x4*)(rk + c0), rk1 = *(const f32x4*)(rk + c0 + 4), lw0 = *(const f32x4*)(lw + c0), lw1 = *(const f32x4*)(lw + c0 + 4), lb0 = *(const f32x4*)(lb + c0), lb1 = *(const f32x4*)(lb + c0 + 4);
#pragma unroll 4
    for (int t = bid * 16 + (tid >> 5); t < T; t += G * 16) {
        const size_t o = (size_t)t * 256 + c0;
        const f32x4 y0 = *(const f32x4*)(YR + o), y1 = *(const f32x4*)(YR + o + 4);
        const u32x4 r4 = *(const u32x4*)(Rr + o), k4 = *(const u32x4*)(Kr + o), v4 = *(const u32x4*)(Vr + o), g4 = *(const u32x4*)(Gr + o);
        const float mean = red8(((y0[0] + y0[1]) + (y0[2] + y0[3])) + ((y1[0] + y1[1]) + (y1[2] + y1[3]))) * (1.0f / 64.0f);
        const f32x4 d0 = y0 - mean, d1 = y1 - mean;
        const float var = red8(((d0[0] * d0[0] + d0[1] * d0[1]) + (d0[2] * d0[2] + d0[3] * d0[3])) + ((d1[0] * d1[0] + d1[1] * d1[1]) + (d1[2] * d1[2] + d1[3] * d1[3]))) * (1.0f / 64.0f);
        const float rstd = rsqrtf(var + 64e-5f);
        float r[8], k[8], v[8], g[8]; unpack8(r4, r); unpack8(k4, k); unpack8(v4, v); unpack8(g4, g);
        float bs = 0.f;
#pragma unroll
        for (int i = 0; i < 8; ++i) bs += r[i] * k[i] * (i < 4 ? rk0[i & 3] : rk1[i & 3]);
        bs = red8(bs);
        float ov[8];
#pragma unroll
        for (int i = 0; i < 8; ++i) { const float dd = i < 4 ? d0[i & 3] : d1[i & 3], lwv = i < 4 ? lw0[i & 3] : lw1[i & 3], lbv = i < 4 ? lb0[i & 3] : lb1[i & 3]; ov[i] = (dd * rstd * lwv + lbv + bs * v[i]) * g[i]; }
        u32x4 w; w.x = pk2(ov[0], ov[1]); w.y = pk2(ov[2], ov[3]); w.z = pk2(ov[4], ov[5]); w.w = pk2(ov[6], ov[7]);
        *(u32x4*)(Y + (size_t)t * D + 256 + c0) = w;
    }
}
constexpr float LOG2E = 1.4426950408889634f;
constexpr int NSA_KV = 64 * 72, NSA_VS = 76, NSA_BUF = NSA_KV + 64 * NSA_VS;
template <int MODE>
__device__ __forceinline__ void attn_tiles(unsigned long long tmask, const bf16_t* __restrict__ Ksrc, const bf16_t* __restrict__ Vsrc, LAS bf16_t* KVB, LAS float* IMPh,
                                           const bf16x8 (&qf)[2][2], float (&lrow)[2], f32x4 (&o)[2][4], const unsigned long long (&selm)[2],
                                           int qi, int qbase, float slope2, float bnd, int tid, int lane, int wave) {
    const int fr = lane & 15, fq = lane >> 4;
    const int key = tid >> 3, part = tid & 7;
    if (!tmask) return;
    const u32x4 zz = (u32x4){0u, 0u, 0u, 0u};
    u32x4 k0 = zz, v0 = zz, k1 = zz, v1 = zz;
    unsigned long long lm = tmask;
#define NSA_LOAD(KR, VR) do { const int j_ = __builtin_ctzll(lm); lm &= lm - 1; KR = *(const u32x4*)(Ksrc + (size_t)(64 * j_ + key) * 64 + part * 8); VR = *(const u32x4*)(Vsrc + (size_t)(64 * j_ + key) * 64 + part * 8); } while (0)
#define NSA_PUT(BUF) do { LAS bf16_t* kt_ = KVB + (BUF) * NSA_BUF; *(LAS u32x4*)(kt_ + key * 72 + part * 8) = k0; LAS bf16_t* vp = kt_ + NSA_KV + (part * 8) * NSA_VS + key; \
        vp[0 * NSA_VS] = (bf16_t)(v0.x & 0xffffu); vp[1 * NSA_VS] = (bf16_t)(v0.x >> 16); vp[2 * NSA_VS] = (bf16_t)(v0.y & 0xffffu); vp[3 * NSA_VS] = (bf16_t)(v0.y >> 16); \
        vp[4 * NSA_VS] = (bf16_t)(v0.z & 0xffffu); vp[5 * NSA_VS] = (bf16_t)(v0.z >> 16); vp[6 * NSA_VS] = (bf16_t)(v0.w & 0xffffu); vp[7 * NSA_VS] = (bf16_t)(v0.w >> 16); } while (0)
    NSA_LOAD(k0, v0);
    if (lm) NSA_LOAD(k1, v1);
    __syncthreads();
    NSA_PUT(0); k0 = k1; v0 = v1;
    if (lm) NSA_LOAD(k1, v1);
    __syncthreads();
    int cur = 0;
    for (;;) {
        const int j = __builtin_ctzll(tmask); tmask &= tmask - 1;
        if (tmask) { NSA_PUT(cur ^ 1); k0 = k1; v0 = v1; if (lm) NSA_LOAD(k1, v1); }
        const LAS bf16_t* KT = KVB + cur * NSA_BUF; const LAS bf16_t* VT = KT + NSA_KV;
        const bool wave_active = (MODE != 2) || (__ballot((((selm[0] | selm[1]) >> j) & 1ull) != 0ull) != 0ull);
        if (wave_active) {
        constexpr int DM = (MODE == 1) ? 16 : 1;
        const float sl = slope2 * (float)DM;
        int dbase[2]; float c0[2];
#pragma unroll
        for (int mt = 0; mt < 2; ++mt) { const int sq = 64 * qi + qbase + 16 * mt + fr;
            dbase[mt] = (MODE == 1) ? sq - 31 - 1024 * j - 64 * fq : sq - 64 * j - 4 * fq;
            c0[mt] = -slope2 * (float)dbase[mt] - bnd;
            if (MODE == 2) { if (((selm[mt] >> j) & 1ull) == 0ull) c0[mt] = -1e30f; } }
        f32x4 st[2][4];
#pragma unroll
        for (int nt = 0; nt < 4; ++nt) {
            const bf16x8 k0 = *(const LAS bf16x8*)(KT + (16 * nt + fr) * 72 + 8 * fq), k1 = *(const LAS bf16x8*)(KT + (16 * nt + fr) * 72 + 32 + 8 * fq);
#pragma unroll
            for (int mt = 0; mt < 2; ++mt) {
                const f32x4 ini = (f32x4){fmaf(sl, (float)(16 * nt), c0[mt]), fmaf(sl, (float)(16 * nt + 1), c0[mt]), fmaf(sl, (float)(16 * nt + 2), c0[mt]), fmaf(sl, (float)(16 * nt + 3), c0[mt])};
                f32x4 s = __builtin_amdgcn_mfma_f32_16x16x32_bf16(k0, qf[mt][0], ini, 0, 0, 0);
                st[mt][nt] = __builtin_amdgcn_mfma_f32_16x16x32_bf16(k1, qf[mt][1], s, 0, 0, 0);
            }
        }
        const bool boundary = (MODE == 1) || (j == qi) || (MODE == 3 && j == qi - 8);
#pragma unroll
        for (int mt = 0; mt < 2; ++mt) {
            float ls = 0.f;
            if (boundary) {
#pragma unroll
                for (int nt = 0; nt < 4; ++nt)
#pragma unroll
                    for (int i = 0; i < 4; ++i) { const int dist = dbase[mt] - DM * (16 * nt + i);
                        bool valid = dist >= 0; if (MODE == 3) valid = valid && (dist < 512);
                        const float p = valid ? __builtin_amdgcn_exp2f(st[mt][nt][i]) : 0.f; st[mt][nt][i] = p; ls += p; }
            } else {
#pragma unroll
                for (int nt = 0; nt < 4; ++nt)
#pragma unroll
                    for (int i = 0; i < 4; ++i) { const float p = __builtin_amdgcn_exp2f(st[mt][nt][i]); st[mt][nt][i] = p; ls += p; }
            }
            lrow[mt] += ls;
            if (MODE == 1) {
                LAS float* ir = IMPh + (qbase + 16 * mt + fr) * 65;
#pragma unroll
                for (int nt = 0; nt < 4; ++nt) { const int jj = 16 * j + 4 * nt + fq; const f32x4 p = st[mt][nt];
                    const float c1 = (p[0] + p[1]) + (p[2] + p[3]), c2 = p[3];
                    if (c1 != 0.f) { atomicAdd((float*)(ir + jj), c1); if (jj + 1 < 64 && c2 != 0.f) atomicAdd((float*)(ir + jj + 1), c2); } }
            }
        }
#pragma unroll
        for (int ks = 0; ks < 2; ++ks) {
            bf16x8 pb[2];
#pragma unroll
            for (int mt = 0; mt < 2; ++mt) { u32x4 w; const f32x4 pa = st[mt][2 * ks], pc = st[mt][2 * ks + 1];
                w.x = pk2(pa[0], pa[1]); w.y = pk2(pa[2], pa[3]); w.z = pk2(pc[0], pc[1]); w.w = pk2(pc[2], pc[3]); pb[mt] = __builtin_bit_cast(bf16x8, w); }
#pragma unroll
            for (int dt = 0; dt < 4; ++dt) {
                const u32x2 lo = *(const LAS u32x2*)(VT + (16 * dt + fr) * NSA_VS + 32 * ks + 4 * fq), hi = *(const LAS u32x2*)(VT + (16 * dt + fr) * NSA_VS + 32 * ks + 16 + 4 * fq);
                const bf16x8 vf = __builtin_bit_cast(bf16x8, ((u32x4){lo.x, lo.y, hi.x, hi.y}));
#pragma unroll
                for (int mt = 0; mt < 2; ++mt) o[mt][dt] = __builtin_amdgcn_mfma_f32_16x16x32_bf16(vf, pb[mt], o[mt][dt], 0, 0, 0);
            }
        }
        }
        if (!tmask) break;
        __syncthreads();
        cur ^= 1;
    }
#undef NSA_LOAD
#undef NSA_PUT
}
__device__ __forceinline__ float wave_max64(float v) {
#pragma unroll
    for (int o = 1; o < 64; o <<= 1) v = fmaxf(v, __shfl_xor(v, o));
    return v;
}
__device__ __forceinline__ void nsa_unit(const Args& a, int l, int b, int qi, float bnd0, float bnd1, float bnd2, LAS unsigned char* lds, int tid, int lane, int wave) {
    LAS bf16_t* KVB = (LAS bf16_t*)lds;
    LAS float* IMP = (LAS float*)(lds + 37888);
    LAS unsigned long long* SELM = (LAS unsigned long long*)(lds + 104448);
    LAS float* INVL = (LAS float*)(lds + 105024);
    const bf16_t* QN = (const bf16_t*)(a.ws + WS_QN); const float* GATES = (const float*)(a.ws + WS_GATES); bf16_t* Y = (bf16_t*)(a.ws + WS_Y);
    const int fr = lane & 15, fq = lane >> 4, h = wave >> 1, qbase = (wave & 1) * 32;
    const size_t t0 = (size_t)b * SEQ + 64 * qi;
    const float slope2 = LOG2E * exp2f(-2.0f * (float)(h + 1));
    bf16x8 qf[2][2]; float gate[2][3];
#pragma unroll
    for (int mt = 0; mt < 2; ++mt) { const size_t t = t0 + qbase + 16 * mt + fr;
#pragma unroll
        for (int ks = 0; ks < 2; ++ks) qf[mt][ks] = *(const bf16x8*)(QN + t * 256 + h * 64 + 32 * ks + 8 * fq);
#pragma unroll
        for (int br = 0; br < 3; ++br) gate[mt][br] = GATES[t * 12 + h * 3 + br]; }
    for (int e = tid; e < 4 * 64 * 65; e += 512) IMP[e] = 0.f;
    f32x4 o[2][4]; LAS f32x4* OACC = (LAS f32x4*)IMP + tid; float lrow[2]; unsigned long long selm[2] = {0ull, 0ull};
    const f32x4 z4 = (f32x4){0.f, 0.f, 0.f, 0.f};
#pragma unroll
    for (int mt = 0; mt < 2; ++mt)
#pragma unroll
        for (int dt = 0; dt < 4; ++dt) o[mt][dt] = z4;
    const bf16_t* KC = (const bf16_t*)(a.ws + WS_KCMP) + (size_t)b * 256 * 64; const bf16_t* VC = (const bf16_t*)(a.ws + WS_VCMP) + (size_t)b * 256 * 64;
    const int ncmp = (4 * qi + 2) / 64 + 1; const unsigned long long cmask = (1ull << ncmp) - 1ull;
    lrow[0] = lrow[1] = 0.f;
    attn_tiles<1>(cmask, KC, VC, KVB, IMP + h * (64 * 65), qf, lrow, o, selm, qi, qbase, slope2, bnd0, tid, lane, wave);
#pragma unroll
    for (int mt = 0; mt < 2; ++mt) { float lt = lrow[mt]; lt += __shfl_xor(lt, 16); lt += __shfl_xor(lt, 32); const float il = lt > 0.f ? 1.0f / lt : 0.f;
        if (fq == 0) INVL[h * 64 + qbase + 16 * mt + fr] = il;
#pragma unroll
        for (int dt = 0; dt < 4; ++dt) o[mt][dt] = o[mt][dt] * (gate[mt][0] * il); }
    __syncthreads();
    {
        unsigned long long uni = 0ull;
        for (int qq = 0; qq < 8; ++qq) { const int q = wave * 8 + qq, j = lane;
            const float v = (IMP[q * 65 + j] * INVL[q] + IMP[4160 + q * 65 + j] * INVL[64 + q]) + (IMP[8320 + q * 65 + j] * INVL[128 + q] + IMP[12480 + q * 65 + j] * INVL[192 + q]);
            const bool forced = (j == 0) || (j == qi) || (j == qi - 1);
            const float val = (j <= qi) ? v + (forced ? 1e4f : 0.f) : -1.0f;
            const unsigned ub = __float_as_uint(val), key = (ub & 0x80000000u) ? ~ub : (ub | 0x80000000u);
            unsigned prefix = 0u;
#pragma unroll
            for (int bit = 31; bit >= 0; --bit) { const unsigned cand = prefix | (1u << bit); if (__builtin_popcountll(__ballot(key >= cand)) >= 16) prefix = cand; }
            const unsigned long long gtm = __ballot(key > prefix), eqm = __ballot(key == prefix);
            const int need = 16 - __builtin_popcountll(gtm);
            const bool pick = (key > prefix) || (key == prefix && __builtin_popcountll(eqm & ((1ull << lane) - 1ull)) < need);
            unsigned long long m = __ballot(pick);
            m &= (qi == 63) ? ~0ull : ((1ull << (qi + 1)) - 1ull);
            if (lane == 0) SELM[q] = m;
            uni |= m; }
        if (lane == 0) SELM[64 + wave] = uni;
    }
    __syncthreads();
    unsigned long long uni = 0ull;
#pragma unroll
    for (int w = 0; w < 8; ++w) uni |= SELM[64 + w];
    uni = ((unsigned long long)__builtin_amdgcn_readfirstlane((unsigned)(uni >> 32)) << 32) | (unsigned long long)__builtin_amdgcn_readfirstlane((unsigned)uni);
    selm[0] = SELM[qbase + fr]; selm[1] = SELM[qbase + 16 + fr];
#pragma unroll
    for (int mt = 0; mt < 2; ++mt)
#pragma unroll
        for (int dt = 0; dt < 4; ++dt) { OACC[(mt * 4 + dt) * 512] = o[mt][dt]; o[mt][dt] = z4; }
    lrow[0] = lrow[1] = 0.f;
    attn_tiles<2>(uni, (const bf16_t*)(a.ws + WS_KSEL) + (size_t)b * SEQ * 64, (const bf16_t*)(a.ws + WS_VSEL) + (size_t)b * SEQ * 64, KVB, IMP, qf, lrow, o, selm, qi, qbase, slope2, bnd1, tid, lane, wave);
#pragma unroll
    for (int mt = 0; mt < 2; ++mt) { float lt = lrow[mt]; lt += __shfl_xor(lt, 16); lt += __shfl_xor(lt, 32); const float sc = lt > 0.f ? gate[mt][1] / lt : 0.f;
#pragma unroll
        for (int dt = 0; dt < 4; ++dt) { OACC[(mt * 4 + dt) * 512] = OACC[(mt * 4 + dt) * 512] + o[mt][dt] * sc; o[mt][dt] = z4; } }
    const int jlo = qi >= 8 ? qi - 8 : 0;
    const unsigned long long wmask = ((qi == 63) ? ~0ull : ((1ull << (qi + 1)) - 1ull)) & ~((1ull << jlo) - 1ull);
    lrow[0] = lrow[1] = 0.f;
    attn_tiles<3>(wmask, (const bf16_t*)(a.ws + WS_KWIN) + (size_t)b * SEQ * 64, (const bf16_t*)(a.ws + WS_VWIN) + (size_t)b * SEQ * 64, KVB, IMP, qf, lrow, o, selm, qi, qbase, slope2, bnd2, tid, lane, wave);
#pragma unroll
    for (int mt = 0; mt < 2; ++mt) { float lt = lrow[mt]; lt += __shfl_xor(lt, 16); lt += __shfl_xor(lt, 32); const float sc = lt > 0.f ? gate[mt][2] / lt : 0.f;
        const size_t t = t0 + qbase + 16 * mt + fr;
#pragma unroll
        for (int dt = 0; dt < 4; ++dt) { const f32x4 r = OACC[(mt * 4 + dt) * 512] + o[mt][dt] * sc;
            u32x2 w; w.x = pk2(r[0], r[1]); w.y = pk2(r[2], r[3]);
            *(u32x2*)(Y + t * D + 512 + h * 64 + 16 * dt + 4 * fq) = w; } }
    __syncthreads();
}
__device__ __forceinline__ void nsa_phase(const Args& a, int l, int qslot, LAS unsigned char* lds, int tid, int lane, int wave) {
    unsigned* ctr = (unsigned*)(a.ws + WS_CTL) + 64 * qslot;
    LAS int* slot = (LAS int*)(lds + 106048);
    const float qmx = wave_max64(fabsf(INTAB(a)[20][l * 64 + lane]));
    const float bnd0 = 11.72f * qmx * wave_max64(fabsf(INTAB(a)[21][l * 192 + lane])), bnd1 = 11.72f * qmx * wave_max64(fabsf(INTAB(a)[21][l * 192 + 64 + lane])), bnd2 = 11.72f * qmx * wave_max64(fabsf(INTAB(a)[21][l * 192 + 128 + lane]));
    for (;;) {
        if (tid == 0) slot[0] = (int)atomicAdd(ctr, 1u);
        __syncthreads();
        const int u = slot[0];
        __syncthreads();
        if (u >= 512) break;
        const int b = u & 7, qi = 63 - (u >> 3);
        nsa_unit(a, l, b, qi, bnd0, bnd1, bnd2, lds, tid, lane, wave);
    }
}
#ifndef PHM
#define PHM 0xffff
#endif
#ifndef DUP
#define DUP 0
#endif
#define REP(bit) if (rep_ == 0 || ((DUP >> (bit)) & 1))
__global__ void __launch_bounds__(512) mk_fwd(Args a) {
    extern __shared__ __attribute__((aligned(16))) unsigned char lds_raw[];
    LAS unsigned char* lds = (LAS unsigned char*)lds_raw;
#define OPQ() int tid = threadIdx.x; asm volatile("" : "+v"(tid)); const int lane = tid & 63, wave = __builtin_amdgcn_readfirstlane(tid >> 6); int bid = blockIdx.x; asm volatile("" : "+s"(bid)); int G = gridDim.x; asm volatile("" : "+s"(G));
    unsigned char* ws = a.ws;
    bf16_t* XB = (bf16_t*)(ws + WS_XB); bf16_t* H = (bf16_t*)(ws + WS_H); bf16_t* P = (bf16_t*)(ws + WS_P); bf16_t* Y = (bf16_t*)(ws + WS_Y); float* SSQ = (float*)(ws + WS_SSQ);
    volatile LAS unsigned* bst = (volatile LAS unsigned*)(lds + 147392);
    if (threadIdx.x < 2) bst[threadIdx.x] = 0u;
    __syncthreads();
#if MK_COOP
    XcdBarrier xbar = xcd_barrier_post((unsigned*)(a.ws + WS_BAR), bst);
    if (a.hi > 4096) cg::this_grid().sync();
#else
    XcdBarrier xbar; xbar.bar = (unsigned*)(a.ws + WS_BAR); xbar.x = 0; xbar.st = bst;
#endif
    for (int it = 2 * a.lo; it < 2 * a.hi; ++it) {
        const int ph = it >> 1, rep_ = it & 1;
        if (rep_) { const int s_ = ph == 0 ? -1 : (ph - 1) % 9; const int bits = ph == 0 ? 1 : (s_ == 0 || s_ == 7) ? 2 : s_ == 2 ? 8 : s_ == 3 ? 0x1f0 : s_ == 4 ? 0x600 : s_ == 5 ? 0x800 : 0; if (!(DUP & bits)) continue; }
        OPQ();
        if (ph == 0) { if (PHM & 1) REP(0) prologue(a, lds, tid, lane, wave, G, bid, rep_); }
        else {
            const int l = (ph - 1) / 9, s = (ph - 1) % 9;
            unsigned char* wb = ws + WS_W0 + (size_t)l * WS_LSTRIDE;
            if ((PHM & 2) && (s == 0 || s == 7)) { {
                pg8::Gemm g{XB, (const bf16_t*)(wb + (s == 0 ? WO_F1 : WO_F2)), T, NGU, D}; pg8::StaticOrder S; S.init(T, NGU, G, bid);
                pg8::EpiGU E{H, SSQ, FF};
                pg8::gemm_phase<pg8::EpiGU, pg8::StaticOrder, true, true>(lds, g, S, E); }
            } else if ((PHM & 4) && (s == 1 || s == 8)) {
                pg8::Gemm g{H, (const bf16_t*)(wb + (s == 1 ? WO_D1 : WO_D2)), T, D, FF}; pg8::StaticOrder S; S.init(T, D, G, bid);
                pg8::EpiRes E{(l == 0 && s == 1) ? a.in[0] : a.out, a.out, XB, SSQ, 0.5f};
                pg8::gemm_phase<pg8::EpiRes, pg8::StaticOrder, true, true>(lds, g, S, E);
            } else if ((PHM & 4) && s == 6) {
                pg8::Gemm g{Y, (const bf16_t*)(wb + WO_OUT), T, D, D}; pg8::StaticOrder S; S.init(T, D, G, bid);
                pg8::EpiRes E{a.out, a.out, XB, SSQ, 1.0f};
                pg8::gemm_phase<pg8::EpiRes, pg8::StaticOrder, true, true>(lds, g, S, E);
            } else if ((PHM & 8) && s == 2) { {
                pg8::Gemm g{XB, (const bf16_t*)(wb + WO_IN), T, PLD, D}; pg8::StaticOrder S; S.init(T, PLD, G, bid);
                pg8::EpiP E{P, SSQ, PLD};
                pg8::gemm_phase<pg8::EpiP, pg8::StaticOrder, true, true>(lds, g, S, E); }
            } else if (s == 3) {
                if (PHM & 16) REP(4) { OPQ(); pool_phase(a, l, lds, tid, lane, wave, G, bid); }
                if (PHM & 32) REP(5) { OPQ(); conv_phase(a, l, tid, G, bid); }
                if (PHM & 64) REP(6) { OPQ(); rwkv_prep_phase(a, l, lds, tid, lane, wave, G, bid); }
                if (PHM & 128) REP(7) { OPQ(); nsa_prep_phase(a, l, tid, G, bid); }
                if (PHM & 256) REP(8) { OPQ(); compress_phase(a, l, lds, tid, lane, wave, G, bid); }
            } else if (s == 4) {
                if (PHM & 512) REP(9) { OPQ(); scan_phase(a, lds, tid, lane, wave, G, bid); }
                if (PHM & 1024) REP(10) { OPQ(); nsa_phase(a, l, l * 2 + rep_, lds, tid, lane, wave); }
            } else if (s == 5) {
                if (PHM & 2048) REP(11) rwkv_out_phase(a, l, tid, G, bid);
            }
        }
        if (ph + 1 < a.hi) {
            xcd_barrier(xbar);
        }
    }
}

extern "C" void kernel_launch(void* const* d_in, const int* in_sizes, int n_in, void* d_out, int out_size, void* d_ws, size_t ws_size, hipStream_t stream) {
    static int grid = 0;
    if (grid == 0) {
        if (n_in != 33 || out_size != T * D || ws_size < WS_END) { fprintf(stderr, "kernel_launch: unexpected sizes n_in %d out %d ws %zu\n", n_in, out_size, ws_size); grid = -1; return; }
        int dev = 0, cus = 0, per_cu = 0;
        hipGetDevice(&dev); hipDeviceGetAttribute(&cus, hipDeviceAttributeMultiprocessorCount, dev);
        hipFuncSetAttribute((const void*)mk_fwd, hipFuncAttributeMaxDynamicSharedMemorySize, LDS_BYTES);
        if (hipOccupancyMaxActiveBlocksPerMultiprocessor(&per_cu, (const void*)mk_fwd, 512, LDS_BYTES) != hipSuccess || per_cu < 1) per_cu = 1;
        (void)hipGetLastError();
        grid = cus * per_cu;
    }
    if (grid < 0) return;
    Args a{};
    for (int i = 0; i < 33; ++i) a.in[i] = (const float*)d_in[i];
    a.out = (float*)d_out; a.ws = (unsigned char*)d_ws;
#if MK_COOP
    a.lo = 0; a.hi = NPH;
    if (hipMemsetAsync((char*)d_ws + WS_BAR, 0, XCD_BAR_WORDS * 4, stream) != hipSuccess) fprintf(stderr, "barrier memset failed\n");
    void* args[] = {&a};
    hipError_t e = hipLaunchCooperativeKernel((const void*)mk_fwd, dim3(grid), dim3(512), args, LDS_BYTES, stream);
    if (e != hipSuccess) fprintf(stderr, "cooperative launch failed: %s (grid %d)\n", hipGetErrorString(e), grid);
#else
    for (int ph = 0; ph < NPH; ++ph) { a.lo = ph; a.hi = ph + 1; hipLaunchKernelGGL(mk_fwd, dim3(grid), dim3(512), LDS_BYTES, stream, a); }
#endif
}
```
